# Optimizing an MI355X kernel written in HIP

```python
import jax, jax.numpy as jnp
from jax import lax
import numpy as np

D_MODEL = 1024
BATCH = 16
SEQ = 2048
DEPTH = 1
DEC_BATCH = 2
DEC_SEQ = 8192
PAST_LEN = 128

HEAD_DIM = 64
N_Q_HEADS = 8
N_KV_HEADS = 2
GQA_GROUP = N_Q_HEADS // N_KV_HEADS
ATTN_WIDTH = N_Q_HEADS * HEAD_DIM
KV_WIDTH = N_KV_HEADS * HEAD_DIM
WINDOW = 128
BLOCK = 128
ROPE_THETA = 500000.0
ROT_DIM = HEAD_DIM // 4
N_FOURIER_GROUPS = 4
FOURIER_GROUP_WIDTH = 128
FOURIER_WIDTH = N_FOURIER_GROUPS * FOURIER_GROUP_WIDTH
N_BRANCHES = 2
IN_WIDTH = ATTN_WIDTH + 2 * KV_WIDTH + FOURIER_WIDTH + N_BRANCHES * D_MODEL
SPLITS = [ATTN_WIDTH, ATTN_WIDTH + KV_WIDTH, ATTN_WIDTH + 2 * KV_WIDTH,
          ATTN_WIDTH + 2 * KV_WIDTH + FOURIER_WIDTH]
D_FF = 4 * D_MODEL
N_META = 16
META_PAD = BLOCK - N_META
RMS_EPS = 1e-6
NEG_INF = -1e30

kernel_name = "hybrid_gated_swa_fnet_encoder"


def rms_norm(x, g):
    xf = x.astype(jnp.float32)
    y = xf * lax.rsqrt(jnp.mean(xf * xf, axis=-1, keepdims=True) + RMS_EPS)
    return (y * g.astype(jnp.float32)).astype(x.dtype)


def rope_partial(x, pos):
    half = ROT_DIM // 2
    inv_freq = ROPE_THETA ** (-jnp.arange(half, dtype=jnp.float32) / half)
    ang = pos[:, None] * inv_freq[None, :]
    cos = jnp.cos(ang)[None, :, None, :].astype(x.dtype)
    sin = jnp.sin(ang)[None, :, None, :].astype(x.dtype)
    x1, x2, rest = x[..., :half], x[..., half:ROT_DIM], x[..., ROT_DIM:]
    return jnp.concatenate([x1 * cos - x2 * sin, x2 * cos + x1 * sin, rest], axis=-1)


def _band(a, nb, axis):
    return jnp.concatenate([lax.slice_in_dim(a, i, i + nb, axis=axis) for i in range(3)], axis=axis + 1)


def window_attention(q, k, v, sink):
    B, L = q.shape[0], q.shape[1]
    T = META_PAD + L
    nb = T // BLOCK
    scale = HEAD_DIM ** -0.5
    k_meta, v_meta = k[:, :N_META], v[:, :N_META]
    qb = jnp.pad(q, ((0, 0), (META_PAD, 0), (0, 0), (0, 0))).reshape(
        B, nb, BLOCK, N_KV_HEADS, GQA_GROUP, HEAD_DIM)
    kv_pad = ((0, 0), (META_PAD + BLOCK, BLOCK), (0, 0), (0, 0))
    kb = _band(jnp.pad(k, kv_pad).reshape(B, nb + 2, BLOCK, N_KV_HEADS, HEAD_DIM), nb, 1)
    vb = _band(jnp.pad(v, kv_pad).reshape(B, nb + 2, BLOCK, N_KV_HEADS, HEAD_DIM), nb, 1)
    pos_q = (jnp.arange(T) - META_PAD).reshape(nb, BLOCK)
    pos_k = _band((jnp.arange(T + 2 * BLOCK) - META_PAD - BLOCK).reshape(nb + 2, BLOCK), nb, 0)
    key_real = (pos_k >= N_META) & (pos_k < L)
    mask = (jnp.abs(pos_q[:, :, None] - pos_k[:, None, :]) <= WINDOW) & key_real[:, None, :]
    s_band = jnp.einsum('bnqhgd,bnkhd->bnhgqk', qb, kb, preferred_element_type=jnp.float32) * scale
    s_band = jnp.where(mask[None, :, None, None], s_band, NEG_INF)
    s_meta = jnp.einsum('bnqhgd,bmhd->bnhgqm', qb, k_meta, preferred_element_type=jnp.float32) * scale
    sink_l = jnp.broadcast_to(sink.astype(jnp.float32).reshape(1, 1, N_KV_HEADS, GQA_GROUP, 1, 1),
                              s_meta.shape[:-1] + (1,))
    p = jax.nn.softmax(jnp.concatenate([sink_l, s_meta, s_band], axis=-1), axis=-1)
    p_meta = p[..., 1:1 + N_META].astype(v.dtype)
    p_band = p[..., 1 + N_META:].astype(v.dtype)
    o = (jnp.einsum('bnhgqm,bmhd->bnqhgd', p_meta, v_meta)
         + jnp.einsum('bnhgqk,bnkhd->bnqhgd', p_band, vb))
    return o.reshape(B, T, ATTN_WIDTH)[:, META_PAD:]


def fourier_mix(u):
    B, L = u.shape[0], u.shape[1]
    ug = u.astype(jnp.float32).reshape(B, L, N_FOURIER_GROUPS, FOURIER_GROUP_WIDTH)
    f = jnp.fft.fft2(ug, axes=(1, 3), norm="ortho").real
    return f.reshape(B, L, FOURIER_WIDTH).astype(u.dtype)


def mixer_block(h, pos, norm_g, w_in, b_gate, sink, w_attn_out, w_fourier, w_out):
    B, L = h.shape[0], h.shape[1]
    z = rms_norm(h, norm_g) @ w_in
    q, k, v, u, g = jnp.split(z, SPLITS, axis=-1)
    q = rope_partial(q.reshape(B, L, N_Q_HEADS, HEAD_DIM), pos)
    k = rope_partial(k.reshape(B, L, N_KV_HEADS, HEAD_DIM), pos)
    v = v.reshape(B, L, N_KV_HEADS, HEAD_DIM)
    a = window_attention(q, k, v, sink) @ w_attn_out
    f = fourier_mix(u) @ w_fourier
    gates = jax.nn.sigmoid((g + b_gate).astype(jnp.float32)).astype(h.dtype)
    merged = gates[..., :D_MODEL] * a + gates[..., D_MODEL:] * f
    return merged @ w_out


def sq_relu_mlp(h, norm_g, w_up, w_down):
    t = rms_norm(h, norm_g) @ w_up
    return jnp.square(jax.nn.relu(t)) @ w_down


def trunk(x, meta_tokens, norm_mix_g, w_in, b_gate, attn_sink, w_attn_out, w_fourier, w_out,
          norm_mlp_g, w_mlp_up, w_mlp_down, norm_final_g):
    B = x.shape[0]
    meta = jnp.broadcast_to(meta_tokens[None].astype(x.dtype), (B, N_META, D_MODEL))
    h = jnp.concatenate([meta, x], axis=1)
    pos = jnp.arange(h.shape[1], dtype=jnp.float32)
    for l in range(DEPTH):
        h = h + mixer_block(h, pos, norm_mix_g[l], w_in[l], b_gate[l], attn_sink[l],
                            w_attn_out[l], w_fourier[l], w_out[l])
        h = h + sq_relu_mlp(h, norm_mlp_g[l], w_mlp_up[l], w_mlp_down[l])
    h = rms_norm(h, norm_final_g)
    return h[:, N_META:]


def setup_inputs(seed: int = 0) -> dict:
    key = jax.random.key(seed)
    ks = jax.random.split(key, 16)
    nrm = lambda k, shape, s: jax.random.normal(k, shape, jnp.float32) * s
    return {
        "x_prompt": nrm(ks[0], (BATCH, SEQ, D_MODEL), 1.0),
        "x_sample": nrm(ks[1], (DEC_BATCH, DEC_SEQ, D_MODEL), 1.0),
        "meta_tokens": nrm(ks[2], (N_META, D_MODEL), 1.0),
        "norm_mix_g": 1.0 + nrm(ks[3], (DEPTH, D_MODEL), 0.02),
        "w_in": nrm(ks[4], (DEPTH, D_MODEL, IN_WIDTH), D_MODEL ** -0.5),
        "b_gate": nrm(ks[5], (DEPTH, N_BRANCHES * D_MODEL), 0.1),
        "attn_sink": nrm(ks[6], (DEPTH, N_Q_HEADS), 0.5),
        "w_attn_out": nrm(ks[7], (DEPTH, ATTN_WIDTH, D_MODEL), ATTN_WIDTH ** -0.5),
        "w_fourier": nrm(ks[8], (DEPTH, FOURIER_WIDTH, D_MODEL), FOURIER_WIDTH ** -0.5),
        "w_out": nrm(ks[9], (DEPTH, D_MODEL, D_MODEL), D_MODEL ** -0.5),
        "norm_mlp_g": 1.0 + nrm(ks[10], (DEPTH, D_MODEL), 0.02),
        "w_mlp_up": nrm(ks[11], (DEPTH, D_MODEL, D_FF), D_MODEL ** -0.5),
        "w_mlp_down": nrm(ks[12], (DEPTH, D_FF, D_MODEL), D_FF ** -0.5),
        "norm_final_g": 1.0 + nrm(ks[13], (D_MODEL,), 0.02),
    }


def reference(x_prompt, x_sample, meta_tokens, norm_mix_g, w_in, b_gate, attn_sink, w_attn_out,
              w_fourier, w_out, norm_mlp_g, w_mlp_up, w_mlp_down, norm_final_g):
    y_prompt = trunk(x_prompt, meta_tokens, norm_mix_g, w_in, b_gate, attn_sink, w_attn_out,
                     w_fourier, w_out, norm_mlp_g, w_mlp_up, w_mlp_down, norm_final_g)
    y_sample = trunk(x_sample, meta_tokens, norm_mix_g, w_in, b_gate, attn_sink, w_attn_out,
                     w_fourier, w_out, norm_mlp_g, w_mlp_up, w_mlp_down, norm_final_g)
    return (y_prompt, y_sample)
```

```cpp
#include <hip/hip_runtime.h>
#include <cstdio>
#include <cstdint>
#include <cmath>
namespace pg8 {
#define PG8_LAS __attribute__((address_space(3)))
typedef unsigned short bf16_t;
typedef short bf16x8 __attribute__((ext_vector_type(8)));
typedef float f32x4 __attribute__((ext_vector_type(4)));
typedef unsigned u32x4 __attribute__((ext_vector_type(4)));
constexpr int BM = 256, BK = 64, HALF = 128, HTB = HALF * BK * 2  , STAGE_BYTES = 8 * HTB, NXCD = 8, WGM = 8;

__host__ __device__ __forceinline__ int lds_byte(int r, int c) { const int st = (r >> 4) * 2 + (c >> 5), rr = r & 15, cc = c & 31, ob = rr * 64 + cc * 2; return st * 1024 + (ob ^ (((ob >> 9) & 1) << 5)); }
__host__ __device__ __forceinline__ void stage_rc(int b, int& R, int& C) { const int st = b / 1024, sb = b % 1024, swz = sb ^ (((sb >> 9) & 1) << 5); R = (st >> 1) * 16 + swz / 64; C = (st & 1) * 32 + (swz % 64) / 2; }
__host__ __device__ __forceinline__ int perm32(int rho) { const int n = rho >> 4, i = rho & 15; return 8 * (i >> 2) + 4 * n + (i & 3); }

struct Unit { int pm, pn; };
struct Gemm { const bf16_t* A; const bf16_t* Bt; int M, N, K; };

struct StaticOrder {
    int nM, nN, nwg, G, c;
    __host__ __device__ void init(int M, int N, int G_, int c_) { nM = M / BM; nN = N / BM; nwg = nM * nN; G = G_; c = c_; }
    __host__ __device__ bool next(int i, Unit& u) const {
        const long L = (long)i * G + c; if (L >= nwg) return false;
        int wgid = (int)L; { const int q = nwg / NXCD, r = nwg % NXCD, xcd = wgid % NXCD, off = wgid / NXCD; wgid = (xcd < r ? xcd * (q + 1) : r * (q + 1) + (xcd - r) * q) + off; }
        const int nig = WGM * nN, gid = wgid / nig, fm = gid * WGM, gsz = (nM - fm) < WGM ? (nM - fm) : WGM;
        u.pm = fm + ((wgid % nig) % gsz); u.pn = (wgid % nig) / gsz; return true;
    }
    __device__ __forceinline__ void a_ready(const Unit&) const {}
    __device__ __forceinline__ void done(const Unit&) const {}
};

__device__ __forceinline__ unsigned cvt_pk_bf16(float lo, float hi) { unsigned r; asm volatile("v_cvt_pk_bf16_f32 %0, %1, %2" : "=v"(r) : "v"(lo), "v"(hi)); return r; }
typedef float f32x2 __attribute__((ext_vector_type(2)));
template <class Epi, class Sched, bool ALIGN_EPI = false, bool SP2 = false>
__device__ __forceinline__ void gemm_phase(PG8_LAS unsigned char* lds, const Gemm g, const Sched& S, const Epi& E) {
    const int tid = threadIdx.x, wid = __builtin_amdgcn_readfirstlane(tid >> 6), lane = tid & 63, wr = wid >> 2, wc = wid & 3, fr = lane & 15, fq = lane >> 4;
    const int K = g.K, nt = K / BK;
    unsigned voffA[2], voffB[2];
#pragma unroll
    for (int i = 0; i < 2; ++i) { int R, C; stage_rc(tid * 16 + i * 8192, R, C); const int Rb = Epi::PERM ? ((R & ~31) + perm32(R & 31)) : R;
        voffA[i] = (unsigned)(R * K + C) * 2u; voffB[i] = (unsigned)(Rb * K + C) * 2u; }
    const size_t kstep = (size_t)(BK * 2);
    const size_t hstep = (size_t)HALF * K * 2;
    const size_t tstep = 2 * hstep;
    const unsigned ldsw = (unsigned)wid * 1024u;
    const int aoff = lds_byte(wr * 64 + fr, fq * 8), boff = lds_byte(wc * 32 + fr, fq * 8);
#define PG8_SA(b, h) (((b) * 2 + (h)) * HTB)
#define PG8_SB(b, h) ((4 + (b) * 2 + (h)) * HTB)
#define PG8_STAGE(bufoff, gbase, voff) do { _Pragma("unroll") for (int _i = 0; _i < 2; ++_i) \
        __builtin_amdgcn_global_load_lds((const unsigned*)((const char*)(gbase) + (voff)[_i]), (PG8_LAS unsigned*)(lds + (bufoff) + ldsw + _i * 8192), 16, 0, 0); } while (0)
#define PG8_LDA(dst, b, h) do { _Pragma("unroll") for (int m = 0; m < 4; ++m) _Pragma("unroll") for (int k = 0; k < 2; ++k) dst[m][k] = *(const PG8_LAS bf16x8*)(lds + PG8_SA(b, h) + aoff + m * 2048 + k * 1024); } while (0)
#define PG8_LDB(dst, b, h) do { _Pragma("unroll") for (int n = 0; n < 2; ++n) _Pragma("unroll") for (int k = 0; k < 2; ++k) dst[n][k] = *(const PG8_LAS bf16x8*)(lds + PG8_SB(b, h) + boff + n * 2048 + k * 1024); } while (0)
#define PG8_MMA(ai, bj, At, Bt) do { __builtin_amdgcn_s_setprio(1); _Pragma("unroll") for (int m = 0; m < 4; ++m) _Pragma("unroll") for (int n = 0; n < 2; ++n) _Pragma("unroll") for (int k = 0; k < 2; ++k) \
        acc[ai][bj][m][n] = __builtin_amdgcn_mfma_f32_16x16x32_bf16(Bt[n][k], At[m][k], acc[ai][bj][m][n], 0, 0, 0); __builtin_amdgcn_s_setprio(0); } while (0)
#define PG8_WAIT_V(n) asm volatile("s_waitcnt vmcnt(" #n ")" ::: "memory")
#define PG8_WAIT_L(n) asm volatile("s_waitcnt lgkmcnt(" #n ")" ::: "memory")
#define PG8_BAR __builtin_amdgcn_s_barrier()
#define PG8_SCHED __builtin_amdgcn_sched_barrier(0)
    Unit cur, nxt; int ui = 0;
    if (!S.next(0, cur)) return;
    f32x4 acc[2][2][4][2];
#pragma unroll
    for (int a = 0; a < 2; ++a)
#pragma unroll
        for (int b = 0; b < 2; ++b)
#pragma unroll
            for (int m = 0; m < 4; ++m)
#pragma unroll
                for (int n = 0; n < 2; ++n) acc[a][b][m][n] = (f32x4){0.f, 0.f, 0.f, 0.f};
    bf16x8 At[4][2], B0[2][2], B1[2][2];
    const char* cA = (const char*)g.A + (size_t)cur.pm * tstep; const char* cB = (const char*)g.Bt + (size_t)cur.pn * tstep;
    S.a_ready(cur);
    if constexpr (SP2) {
        PG8_STAGE(PG8_SB(0, 0), cB, voffB); PG8_STAGE(PG8_SB(0, 1), cB + hstep, voffB); PG8_STAGE(PG8_SA(0, 0), cA, voffA); PG8_STAGE(PG8_SA(0, 1), cA + hstep, voffA);
        if (wr == 1) PG8_BAR;
        PG8_WAIT_V(2); PG8_BAR;
        PG8_STAGE(PG8_SB(1, 0), cB + kstep, voffB); PG8_STAGE(PG8_SA(1, 0), cA + kstep, voffA); PG8_STAGE(PG8_SB(1, 1), cB + hstep + kstep, voffB);
        PG8_WAIT_V(6); PG8_BAR;
    } else {
        PG8_STAGE(PG8_SB(0, 0), cB, voffB); PG8_STAGE(PG8_SA(0, 0), cA, voffA); PG8_STAGE(PG8_SB(0, 1), cB + hstep, voffB); PG8_STAGE(PG8_SA(0, 1), cA + hstep, voffA);
        if (wr == 1) PG8_BAR;
        PG8_WAIT_V(4); PG8_BAR;
        PG8_STAGE(PG8_SB(1, 0), cB + kstep, voffB); PG8_STAGE(PG8_SA(1, 0), cA + kstep, voffA); PG8_STAGE(PG8_SB(1, 1), cB + hstep + kstep, voffB);
        PG8_WAIT_V(6); PG8_BAR;
    }
    for (;;) {
        const bool has_next = S.next(ui + 1, nxt);
        const char* nA = has_next ? (const char*)g.A + (size_t)nxt.pm * tstep : cA; const char* nB = has_next ? (const char*)g.Bt + (size_t)nxt.pn * tstep : cB;
        for (int t = 0; t < nt; t += 2) {
            const bool last = (t == nt - 2);
            const char* a1 = cA + (size_t)(t + 1) * kstep;
            const char* a2 = last ? nA : cA + (size_t)(t + 2) * kstep; const char* b2 = last ? nB : cB + (size_t)(t + 2) * kstep;
            const char* a3 = a2 + kstep; const char* b3 = b2 + kstep;
            if (last && has_next) S.a_ready(nxt);
            if constexpr (SP2) {
            PG8_LDB(B0, 0, 0); PG8_LDB(B1, 0, 1); PG8_SCHED; PG8_LDA(At, 0, 0); PG8_STAGE(PG8_SA(1, 1), a1 + hstep, voffA);
            PG8_WAIT_V(8); PG8_WAIT_L(0); PG8_BAR; PG8_MMA(0, 0, At, B0); PG8_MMA(0, 1, At, B1); PG8_BAR; PG8_SCHED;
            PG8_LDA(At, 0, 1); PG8_STAGE(PG8_SB(0, 0), b2, voffB); PG8_STAGE(PG8_SB(0, 1), b2 + hstep, voffB); PG8_STAGE(PG8_SA(0, 0), a2, voffA);
            PG8_WAIT_V(8); PG8_WAIT_L(0); PG8_BAR; PG8_MMA(1, 0, At, B0); PG8_MMA(1, 1, At, B1); PG8_BAR; PG8_SCHED;
            PG8_LDB(B0, 1, 0); PG8_LDB(B1, 1, 1); PG8_SCHED; PG8_LDA(At, 1, 0); PG8_STAGE(PG8_SA(0, 1), a2 + hstep, voffA);
            PG8_WAIT_V(8); PG8_WAIT_L(0); PG8_BAR; PG8_MMA(0, 0, At, B0); PG8_MMA(0, 1, At, B1); PG8_BAR; PG8_SCHED;
            PG8_LDA(At, 1, 1); PG8_STAGE(PG8_SB(1, 0), b3, voffB); PG8_STAGE(PG8_SB(1, 1), b3 + hstep, voffB); PG8_STAGE(PG8_SA(1, 0), a3, voffA);
            PG8_WAIT_V(8); PG8_WAIT_L(0); PG8_BAR; PG8_MMA(1, 0, At, B0); PG8_MMA(1, 1, At, B1); PG8_BAR; PG8_SCHED;
            } else {
            PG8_LDB(B0, 0, 0); PG8_SCHED; PG8_LDA(At, 0, 0); PG8_STAGE(PG8_SA(1, 1), a1 + hstep, voffA);
            PG8_WAIT_L(8); PG8_BAR; PG8_WAIT_L(0); PG8_MMA(0, 0, At, B0); PG8_BAR; PG8_SCHED;
            PG8_LDB(B1, 0, 1); PG8_STAGE(PG8_SB(0, 0), b2, voffB);
            PG8_BAR; PG8_WAIT_L(0); PG8_MMA(0, 1, At, B1); PG8_BAR;
            PG8_LDA(At, 0, 1); PG8_STAGE(PG8_SA(0, 0), a2, voffA);
            PG8_BAR; PG8_WAIT_L(0); PG8_MMA(1, 0, At, B0); PG8_BAR; PG8_SCHED;
            PG8_STAGE(PG8_SB(0, 1), b2 + hstep, voffB);
            PG8_WAIT_V(6); PG8_BAR; PG8_MMA(1, 1, At, B1); PG8_BAR;
            PG8_LDB(B0, 1, 0); PG8_SCHED; PG8_LDA(At, 1, 0); PG8_STAGE(PG8_SA(0, 1), a2 + hstep, voffA);
            PG8_WAIT_L(8); PG8_BAR; PG8_WAIT_L(0); PG8_MMA(0, 0, At, B0); PG8_BAR; PG8_SCHED;
            PG8_LDB(B1, 1, 1); PG8_STAGE(PG8_SB(1, 0), b3, voffB);
            PG8_BAR; PG8_WAIT_L(0); PG8_MMA(0, 1, At, B1); PG8_BAR;
            PG8_LDA(At, 1, 1); PG8_STAGE(PG8_SA(1, 0), a3, voffA);
            PG8_BAR; PG8_WAIT_L(0); PG8_MMA(1, 0, At, B0); PG8_BAR; PG8_SCHED;
            PG8_STAGE(PG8_SB(1, 1), b3 + hstep, voffB);
            PG8_WAIT_V(6); PG8_BAR; PG8_MMA(1, 1, At, B1); PG8_BAR;
            }
        }
        if constexpr (ALIGN_EPI) { if (wr == 0) PG8_BAR; }
        if constexpr (!Epi::AFTER_DRAIN) { E(acc, cur, wr, wc, fr, fq); S.done(cur); }
        if (!has_next) break;
#pragma unroll
        for (int a = 0; a < 2; ++a)
#pragma unroll
            for (int b = 0; b < 2; ++b)
#pragma unroll
                for (int m = 0; m < 4; ++m)
#pragma unroll
                    for (int n = 0; n < 2; ++n) acc[a][b][m][n] = (f32x4){0.f, 0.f, 0.f, 0.f};
        cur = nxt; cA = nA; cB = nB; ++ui;
        if constexpr (ALIGN_EPI) { if (wr == 1) PG8_BAR; }
    }
    PG8_WAIT_V(0);
    if constexpr (!ALIGN_EPI) { if (wr == 0) PG8_BAR; }
    PG8_BAR;
    if constexpr (Epi::AFTER_DRAIN) { E.fused(acc, cur, wr, wc, fr, fq, lds, wid, lane); S.done(cur); }
#undef PG8_SA
#undef PG8_SB
#undef PG8_STAGE
#undef PG8_LDA
#undef PG8_LDB
#undef PG8_MMA
#undef PG8_WAIT_V
#undef PG8_WAIT_L
#undef PG8_BAR
#undef PG8_SCHED
}
}

#define GAS __attribute__((address_space(1)))
#define LAS __attribute__((address_space(3)))
typedef unsigned short bf16;
typedef unsigned v4u __attribute__((ext_vector_type(4)));
typedef float f32x4 __attribute__((ext_vector_type(4)));
typedef short bf16x8 __attribute__((ext_vector_type(8)));
typedef GAS unsigned gu32;
typedef GAS unsigned long long gu64;
#define RLX_AGENT __ATOMIC_RELAXED, __HIP_MEMORY_SCOPE_AGENT
#define LDS_WAIT() asm volatile("s_waitcnt lgkmcnt(0)" ::: "memory")
#define VM_WAIT() asm volatile("s_waitcnt vmcnt(0)" ::: "memory")
__device__ __forceinline__ unsigned long long rt() { return __builtin_amdgcn_s_memrealtime(); }
__device__ __forceinline__ unsigned f2bf(float f) { unsigned u = __builtin_bit_cast(unsigned, f); return (u + 0x7fffu + ((u >> 16) & 1u)) >> 16; }
__device__ __forceinline__ unsigned pk2(float lo, float hi) { return f2bf(lo) | (f2bf(hi) << 16); }
#define XB_TMO      128
#define XB_XCNT(j)  (256  + 64 * (j))
#define XB_XSUB(j)  (1280 + 64 * (j))
#define XB_XGEN(j)  (2304 + 64 * (j))
#define XB_TOP      3328
#define XB_TOPGEN   3392
#define XCD_BAR_WORDS 3456
#define XB_SPIN_CAP (1u << 18)

__device__ __forceinline__ unsigned xb_ld(unsigned* p)              { return __hip_atomic_load(p, __ATOMIC_RELAXED, __HIP_MEMORY_SCOPE_AGENT); }
__device__ __forceinline__ unsigned xb_add(unsigned* p, unsigned v) { return __hip_atomic_fetch_add(p, v, __ATOMIC_RELAXED, __HIP_MEMORY_SCOPE_AGENT); }
__device__ __forceinline__ unsigned xb_xcc_id() { return (unsigned)__builtin_amdgcn_s_getreg((3 << 11) | 20) & 0xFu; }
#define XB_SPIN(cond, bar) do { unsigned _sp = 0; while (cond) { __builtin_amdgcn_s_sleep(1); \
    if ((++_sp & 255u) == 0u) { if (xb_ld(&(bar)[XB_TMO])) break; if (_sp > XB_SPIN_CAP) { atomicAdd(&(bar)[XB_TMO], 1u); break; } } } } while (0)

struct XcdBarrier {
    unsigned* bar; unsigned x;
    volatile LAS unsigned* st;
};

__device__ __forceinline__ XcdBarrier xcd_barrier_post(unsigned* bar, volatile LAS unsigned* st) {
    XcdBarrier b; b.bar = bar; b.x = xb_xcc_id(); b.st = st;
    if (threadIdx.x == 0) (void)xb_add(&bar[XB_XCNT(b.x)], 1u);
    return b;
}
__device__ __forceinline__ void xcd_barrier_complete(unsigned* bar, unsigned x, unsigned& nloc, unsigned& nx) {
    const unsigned G = gridDim.x * gridDim.y * gridDim.z;
    unsigned sum, cnt, mine, sp = 0u;
    for (;;) {
        sum = 0u; cnt = 0u; mine = 0u;
#pragma unroll
        for (unsigned j = 0; j < 16; ++j) { const unsigned c = xb_ld(&bar[XB_XCNT(j)]); sum += c; cnt += (c > 0u) ? 1u : 0u; mine = (j == x) ? c : mine; }
        if (sum == G) break;
        __builtin_amdgcn_s_sleep(1);
        if ((++sp & 255u) == 0u) { if (xb_ld(&bar[XB_TMO])) break; if (sp > XB_SPIN_CAP) { atomicAdd(&bar[XB_TMO], 1u); break; } }
    }
    nloc = mine > 0u ? mine : 1u; nx = cnt > 0u ? cnt : 1u;
}

__device__ __forceinline__ void xcd_barrier(const XcdBarrier& b) {
    asm volatile("s_waitcnt vmcnt(0)" ::: "memory");
    __syncthreads();
    if (threadIdx.x == 0) {
        unsigned* bar = b.bar;
        __builtin_amdgcn_s_waitcnt(0);
        unsigned nloc = b.st[0], nx = b.st[1];
        if (nloc == 0u) { xcd_barrier_complete(bar, b.x, nloc, nx); b.st[0] = nloc; b.st[1] = nx; }
        const unsigned old = xb_add(&bar[XB_XSUB(b.x)], 1u);
        const unsigned gen = old / nloc;
        if (old + 1u == (gen + 1u) * nloc) {
            __builtin_amdgcn_fence(__ATOMIC_RELEASE, "agent");
            asm volatile("s_waitcnt vmcnt(0)" ::: "memory");
            const unsigned og = xb_add(&bar[XB_TOP], 1u);
            const unsigned tg = og / nx;
            if (og + 1u == (tg + 1u) * nx) xb_add(&bar[XB_TOPGEN], 1u);
            else XB_SPIN(xb_ld(&bar[XB_TOPGEN]) == tg, bar);
            __builtin_amdgcn_fence(__ATOMIC_ACQUIRE, "agent");
            xb_add(&bar[XB_XGEN(b.x)], 1u);
            asm volatile("s_waitcnt vmcnt(0)" ::: "memory");
        } else {
            XB_SPIN(xb_ld(&bar[XB_XGEN(b.x)]) == gen, bar);
            __builtin_amdgcn_fence(__ATOMIC_ACQUIRE, "agent");
            asm volatile("s_waitcnt vmcnt(0)" ::: "memory");
        }
    }
    __syncthreads();
}


constexpr int DM = 1024, FFD = 4096, INW = 3328;
constexpr int SEQP = 2048, SEQS = 8192, NBP = 16, NBS = 2;
constexpr int RP = NBP * SEQP, RS = NBS * SEQS, R = RP + RS;
constexpr int NMETA = 16, LP = SEQP + NMETA, LS = SEQS + NMETA;
constexpr int N1P = 43, N2P = 48, N1S = 76, N2S = 108;
constexpr int UROWS = NBP * LP + NBS * LS;
constexpr float RMS_EPS = 1e-6f, LOG2E = 1.4426950408889634f, QSCALE = 0.125f * 1.4426950408889634f;
constexpr int WINDOW = 128;
#ifndef MK_N_LAUNCHES
#define MK_N_LAUNCHES 10
#endif
constexpr int N_PHASES = 10;

constexpr size_t MiB = 1u << 20;
constexpr size_t WS_CTL = 0, CTL_ZERO_BYTES = 1 * MiB;
constexpr size_t WS_WIN = 2 * MiB, WS_WAO = 9 * MiB, WS_WF = 10 * MiB, WS_WOUT = 12 * MiB, WS_WUP = 14 * MiB, WS_WDN = 22 * MiB;
constexpr size_t WS_SSQ1 = 2 * MiB;
constexpr size_t WS_ROPE = 30 * MiB;
constexpr size_t WS_TABLP = 30 * MiB + 640 * 1024, WS_TABLS = WS_TABLP + 32 * 1024, WS_TABN1P = WS_TABLP + 128 * 1024, WS_TABN1S = WS_TABLP + 132 * 1024;
constexpr size_t WS_KMETA = 31 * MiB, WS_VMETA = 31 * MiB + 4096;
constexpr size_t WS_G = 32 * MiB, WS_Q = 224 * MiB, WS_K = 272 * MiB, WS_V = 284 * MiB, WS_U = 296 * MiB, WS_A = 345 * MiB;
constexpr size_t WS_MERGED = 224 * MiB;
constexpr size_t WS_TT = 32 * MiB;
constexpr size_t WS_H = 416 * MiB;
constexpr size_t WS_END = 512 * MiB;
static_assert(WS_U + (size_t)UROWS * 512 * 2 <= WS_A && WS_A + (size_t)R * 512 * 2 <= WS_H && WS_TT + (size_t)R * FFD * 2 <= WS_H && WS_H + (size_t)R * DM * 2 <= WS_END, "d_ws map");
static_assert(WS_WIN + (size_t)INW * DM * 2 <= WS_WAO && WS_SSQ1 + (size_t)R * 16 * 4 <= WS_WAO, "d_ws map (weights)");
constexpr int CW_BAR = 4096;

constexpr int RING_BYTES = 131072, LDSCTL_OFF = RING_BYTES, MISC_OFF = LDSCTL_OFF + 320, TAB128_OFF = LDSCTL_OFF + 1024, LDS_BYTES = 147456;
constexpr int NWAVES = 8;

__device__ __forceinline__ float bf2f(unsigned short b) { return __builtin_bit_cast(float, (unsigned)b << 16); }
__device__ __forceinline__ float bflo(unsigned u) { return __builtin_bit_cast(float, u << 16); }
__device__ __forceinline__ float bfhi(unsigned u) { return __builtin_bit_cast(float, u & 0xffff0000u); }
__device__ __forceinline__ float wave_sum(float v) {
#pragma unroll
    for (int o = 1; o < 64; o <<= 1) v += __shfl_xor(v, o);
    return v;
}
__device__ __forceinline__ void row_decode(int r, int& seq, int& s, int& S) {
    if (r < RP) { seq = r >> 11; s = r & (SEQP - 1); S = SEQP; } else { const int q = r - RP; seq = NBP + (q >> 13); s = q & (SEQS - 1); S = SEQS; }
}
__device__ __forceinline__ int useq_base(int seq) { return seq < NBP ? seq * LP : NBP * LP + (seq - NBP) * LS; }
__device__ __forceinline__ int rseq_base(int seq) { return seq < NBP ? seq * SEQP : RP + (seq - NBP) * SEQS; }
__device__ __forceinline__ float sigmoidf_fast(float x) { return __builtin_amdgcn_rcpf(1.0f + __builtin_amdgcn_exp2f(-x * LOG2E)); }

typedef pg8::u32x4 u32x4; using pg8::Unit; typedef pg8::bf16_t bf16_t; using pg8::cvt_pk_bf16;
__device__ __forceinline__ u32x4 pack8(const f32x4 a, const f32x4 b) { u32x4 w; w.x = cvt_pk_bf16(a[0], a[1]); w.y = cvt_pk_bf16(a[2], a[3]); w.z = cvt_pk_bf16(b[0], b[1]); w.w = cvt_pk_bf16(b[2], b[3]); return w; }

struct EpiIn {
    static constexpr bool PERM = true, AFTER_DRAIN = false;
    bf16_t *Q, *K, *V, *U, *G; const float* bgate; const float* rope;
    __device__ __forceinline__ void operator()(const f32x4 (&acc)[2][2][4][2], const Unit& u, int wr, int wc, int fr, int fq) const {
        const int pn = u.pn, rowt = u.pm * 256;
        int seq, s0, S; row_decode(rowt, seq, s0, S);
        const int ub = useq_base(seq) + NMETA + s0 - rowt;
        const int lane = fr + 16 * fq;
#pragma unroll
        for (int ai = 0; ai < 2; ++ai)
#pragma unroll
            for (int m = 0; m < 4; ++m) {
                const int rl = ai * 128 + wr * 64 + m * 16 + fr, row = rowt + rl;
#pragma unroll
                for (int bj = 0; bj < 2; ++bj) {
                    f32x4 v0 = acc[ai][bj][m][0], v1 = acc[ai][bj][m][1];
                    const int cc = bj * 128 + wc * 32 + 8 * fq;
                    if (pn < 3 && !(pn == 2 && bj == 1)) {
                        if ((wc & 1) == 0) {
                            f32x4 o0, o1;
#pragma unroll
                            for (int j = 0; j < 4; ++j) { o0[j] = __shfl_xor(v0[j], 16); o1[j] = __shfl_xor(v1[j], 16); }
                            if (fq < 2) {
                                const float* rp = rope + (size_t)(NMETA + s0 + rl) * 16;
                                const f32x4 c0 = *(const f32x4*)(rp), c1 = *(const f32x4*)(rp + 4), s0v = *(const f32x4*)(rp + 8), s1v = *(const f32x4*)(rp + 12);
                                const float sg = (fq == 0) ? -1.f : 1.f;
                                v0 = v0 * c0 + (o0 * s0v) * sg; v1 = v1 * c1 + (o1 * s1v) * sg;
                            }
                        }
                        if (pn < 2) { v0 = v0 * QSCALE; v1 = v1 * QSCALE; *(u32x4*)(Q + (size_t)row * 512 + pn * 256 + cc) = pack8(v0, v1); }
                        else *(u32x4*)(K + (size_t)row * 128 + cc) = pack8(v0, v1);
                    } else if (pn == 2) {
                        *(u32x4*)(V + (size_t)row * 128 + (cc - 128)) = pack8(v0, v1);
                    } else if (pn < 5) {
                        *(u32x4*)(U + (size_t)(ub + row) * 512 + (pn - 3) * 256 + cc) = pack8(v0, v1);
                    } else {
                        const int gc = (pn - 5) * 256 + cc;
                        const f32x4 b0 = *(const f32x4*)(bgate + gc), b1 = *(const f32x4*)(bgate + gc + 4);
#pragma unroll
                        for (int j = 0; j < 4; ++j) { v0[j] = sigmoidf_fast(v0[j] + b0[j]); v1[j] = sigmoidf_fast(v1[j] + b1[j]); }
                        *(u32x4*)(G + (size_t)row * 2048 + gc) = pack8(v0, v1);
                    }
                }
            }
        (void)lane;
    }
};
struct EpiAO {
    static constexpr bool PERM = true, AFTER_DRAIN = false;
    const bf16_t* G; float* tmp;
    __device__ __forceinline__ void operator()(const f32x4 (&acc)[2][2][4][2], const Unit& u, int wr, int wc, int fr, int fq) const {
#pragma unroll
        for (int ai = 0; ai < 2; ++ai)
#pragma unroll
            for (int m = 0; m < 4; ++m) {
                const int row = u.pm * 256 + ai * 128 + wr * 64 + m * 16 + fr;
#pragma unroll
                for (int bj = 0; bj < 2; ++bj) {
                    const int col = u.pn * 256 + bj * 128 + wc * 32 + 8 * fq;
                    const u32x4 g = *(const u32x4*)(G + (size_t)row * 2048 + col);
                    const f32x4 g0 = {bflo(g.x), bfhi(g.x), bflo(g.y), bfhi(g.y)}, g1 = {bflo(g.z), bfhi(g.z), bflo(g.w), bfhi(g.w)};
                    float* tp = tmp + (size_t)row * DM + col;
                    *(f32x4*)tp = acc[ai][bj][m][0] * g0; *(f32x4*)(tp + 4) = acc[ai][bj][m][1] * g1;
                }
            }
    }
};
struct EpiF {
    static constexpr bool PERM = true, AFTER_DRAIN = false;
    const bf16_t* G; const float* tmp; bf16_t* MG;
    __device__ __forceinline__ void operator()(const f32x4 (&acc)[2][2][4][2], const Unit& u, int wr, int wc, int fr, int fq) const {
#pragma unroll
        for (int ai = 0; ai < 2; ++ai)
#pragma unroll
            for (int m = 0; m < 4; ++m) {
                const int row = u.pm * 256 + ai * 128 + wr * 64 + m * 16 + fr;
#pragma unroll
                for (int bj = 0; bj < 2; ++bj) {
                    const int col = u.pn * 256 + bj * 128 + wc * 32 + 8 * fq;
                    const u32x4 g = *(const u32x4*)(G + (size_t)row * 2048 + 1024 + col);
                    const f32x4 g0 = {bflo(g.x), bfhi(g.x), bflo(g.y), bfhi(g.y)}, g1 = {bflo(g.z), bfhi(g.z), bflo(g.w), bfhi(g.w)};
                    const float* tp = tmp + (size_t)row * DM + col;
                    const f32x4 t0 = *(const f32x4*)tp, t1 = *(const f32x4*)(tp + 4);
                    *(u32x4*)(MG + (size_t)row * DM + col) = pack8(t0 + acc[ai][bj][m][0] * g0, t1 + acc[ai][bj][m][1] * g1);
                }
            }
    }
};
struct EpiOut {
    static constexpr bool PERM = true, AFTER_DRAIN = false;
    const float *xp, *xs; float* h1; bf16_t* H1B; float* ssq;
    __device__ __forceinline__ void operator()(const f32x4 (&acc)[2][2][4][2], const Unit& u, int wr, int wc, int fr, int fq) const {
#pragma unroll
        for (int ai = 0; ai < 2; ++ai)
#pragma unroll
            for (int m = 0; m < 4; ++m) {
                const int row = u.pm * 256 + ai * 128 + wr * 64 + m * 16 + fr;
                const float* xr = (row < RP) ? xp + (size_t)row * DM : xs + (size_t)(row - RP) * DM;
                float sq = 0.f;
#pragma unroll
                for (int bj = 0; bj < 2; ++bj) {
                    const int col = u.pn * 256 + bj * 128 + wc * 32 + 8 * fq;
                    const f32x4 a0 = *(const f32x4*)(xr + col) + acc[ai][bj][m][0], a1 = *(const f32x4*)(xr + col + 4) + acc[ai][bj][m][1];
                    float* hp = h1 + (size_t)row * DM + col; *(f32x4*)hp = a0; *(f32x4*)(hp + 4) = a1;
                    *(u32x4*)(H1B + (size_t)row * DM + col) = pack8(a0, a1);
                    sq += (a0[0] * a0[0] + a0[1] * a0[1]) + (a0[2] * a0[2] + a0[3] * a0[3]) + (a1[0] * a1[0] + a1[1] * a1[1]) + (a1[2] * a1[2] + a1[3] * a1[3]);
                }
                sq += __shfl_xor(sq, 16); sq += __shfl_xor(sq, 32);
                if (fq == 0) ssq[(size_t)row * 16 + u.pn * 4 + wc] = sq;
            }
    }
};
struct EpiUp {
    static constexpr bool PERM = true, AFTER_DRAIN = false;
    const float* ssq; bf16_t* TT;
    __device__ __forceinline__ void operator()(const f32x4 (&acc)[2][2][4][2], const Unit& u, int wr, int wc, int fr, int fq) const {
#pragma unroll
        for (int ai = 0; ai < 2; ++ai)
#pragma unroll
            for (int m = 0; m < 4; ++m) {
                const int row = u.pm * 256 + ai * 128 + wr * 64 + m * 16 + fr;
                const float* sp = ssq + (size_t)row * 16;
                const f32x4 p0 = *(const f32x4*)sp, p1 = *(const f32x4*)(sp + 4), p2 = *(const f32x4*)(sp + 8), p3 = *(const f32x4*)(sp + 12);
                const float tot = (((p0[0] + p0[1]) + (p0[2] + p0[3])) + ((p1[0] + p1[1]) + (p1[2] + p1[3]))) + (((p2[0] + p2[1]) + (p2[2] + p2[3])) + ((p3[0] + p3[1]) + (p3[2] + p3[3])));
                const float rinv = 1.0f / sqrtf(tot * (1.0f / DM) + RMS_EPS);
#pragma unroll
                for (int bj = 0; bj < 2; ++bj) {
                    const int col = u.pn * 256 + bj * 128 + wc * 32 + 8 * fq;
                    f32x4 a0 = acc[ai][bj][m][0] * rinv, a1 = acc[ai][bj][m][1] * rinv;
#pragma unroll
                    for (int j = 0; j < 4; ++j) { a0[j] = fmaxf(a0[j], 0.f); a0[j] *= a0[j]; a1[j] = fmaxf(a1[j], 0.f); a1[j] *= a1[j]; }
                    *(u32x4*)(TT + (size_t)row * FFD + col) = pack8(a0, a1);
                }
            }
    }
};
struct EpiDown {
    static constexpr bool PERM = true, AFTER_DRAIN = false;
    float* h;
    __device__ __forceinline__ void operator()(const f32x4 (&acc)[2][2][4][2], const Unit& u, int wr, int wc, int fr, int fq) const {
#pragma unroll
        for (int ai = 0; ai < 2; ++ai)
#pragma unroll
            for (int m = 0; m < 4; ++m) {
                const int row = u.pm * 256 + ai * 128 + wr * 64 + m * 16 + fr;
#pragma unroll
                for (int bj = 0; bj < 2; ++bj) {
                    const int col = u.pn * 256 + bj * 128 + wc * 32 + 8 * fq;
                    float* hp = h + (size_t)row * DM + col;
                    const f32x4 a0 = *(const f32x4*)hp + acc[ai][bj][m][0], a1 = *(const f32x4*)(hp + 4) + acc[ai][bj][m][1];
                    *(f32x4*)hp = a0; *(f32x4*)(hp + 4) = a1;
                }
            }
    }
};

__device__ __forceinline__ void p0_transpose_item(const float* W, int K, int N, bf16* WT, const float* gk, LAS float* scr, int item, int lane) {
    const int nblk = N / 32, kb = item / nblk, nb = item % nblk, k0 = 64 * kb, n0 = 32 * nb;
#pragma unroll 8
    for (int i = 0; i < 32; ++i) { const int kk = 2 * i + (lane >> 5); float w = W[(size_t)(k0 + kk) * N + n0 + (lane & 31)]; if (gk) w *= gk[k0 + kk]; scr[kk * 33 + (lane & 31)] = w; }
    LDS_WAIT(); asm volatile("" ::: "memory");
    const int c = lane & 7;
#pragma unroll
    for (int j = 0; j < 4; ++j) { const int n = (lane >> 3) + 8 * j; const LAS float* s = scr + (8 * c) * 33 + n;
        v4u o; o.x = pk2(s[0 * 33], s[1 * 33]); o.y = pk2(s[2 * 33], s[3 * 33]); o.z = pk2(s[4 * 33], s[5 * 33]); o.w = pk2(s[6 * 33], s[7 * 33]);
        *(GAS v4u*)(WT + (size_t)(n0 + n) * K + k0 + 8 * c) = o; }
    LDS_WAIT(); asm volatile("" ::: "memory");
}
__device__ __forceinline__ float rope_invfreq(int i) { return powf(500000.0f, -(float)i / 8.0f); }

struct Ptrs {
    const float *xp, *xs, *meta, *gmix, *win, *bgate, *sink, *wao, *wf, *wout, *gmlp, *wup, *wdn, *gfin; float* out;
    bf16 *WinT, *WaoT, *WfT, *WoutT, *WupT, *WdnT, *Gt, *Q, *K, *V, *U, *A, *MG, *TT, *XN, *AB, *H1B, *Km, *Vm, *Y;
    float *ssq1, *rope; float2 *tabLP, *tabLS, *tabN1P, *tabN1S;
};

__device__ __forceinline__ void p0_prologue(const Ptrs& P, LAS unsigned char* lds, int vcu, int G, int tid, int lane, int wave) {
    LAS float* scr = (LAS float*)(lds + wave * 16384);
    LAS float* t128 = (LAS float*)(lds + TAB128_OFF);
    if (tid < 128) { t128[tid] = cospif((float)tid / 64.0f); t128[128 + tid] = sinpif((float)tid / 64.0f); }
    __syncthreads();
    const int gw = vcu * NWAVES + wave, NGW = G * NWAVES;
    constexpr int I_IN = (DM / 64) * (INW / 32), I_AO = (512 / 64) * (DM / 32), I_OUT = (DM / 64) * (DM / 32), I_UP = (DM / 64) * (FFD / 32), I_DN = (FFD / 64) * (DM / 32);
    constexpr int NT_ITEMS = I_IN + I_AO + I_OUT + I_UP + I_DN;
    for (int it = gw; it < NT_ITEMS; it += NGW) {
        int r = it;
        if (r < I_IN) { p0_transpose_item(P.win, DM, INW, P.WinT, nullptr, scr, r, lane); continue; } r -= I_IN;
        if (r < I_AO) { p0_transpose_item(P.wao, 512, DM, P.WaoT, nullptr, scr, r, lane); continue; } r -= I_AO;
        if (r < I_OUT) { p0_transpose_item(P.wout, DM, DM, P.WoutT, nullptr, scr, r, lane); continue; } r -= I_OUT;
        if (r < I_UP) { p0_transpose_item(P.wup, DM, FFD, P.WupT, P.gmlp, scr, r, lane); continue; } r -= I_UP;
        p0_transpose_item(P.wdn, FFD, DM, P.WdnT, nullptr, scr, r, lane);
    }
    for (int it = gw; it < 16 * 1024; it += NGW) {
        const int nb = it & 15, kk = it >> 4, part = kk >> 9, g = (kk >> 7) & 3, c = kk & 127, n = nb * 64 + lane;
        const float* wp = P.wf + (size_t)(g * 128) * DM + n; const LAS float* tb = t128 + part * 128;
        float a = 0.f;
#pragma unroll 16
        for (int m = 0; m < 128; ++m) a += tb[(c * m) & 127] * wp[(size_t)m * DM];
        a *= 0.08838834764831845f; if (part) a = -a;
        P.WfT[(size_t)n * DM + kk] = (bf16)f2bf(a);
    }
    for (int r = gw; r < R; r += NGW) {
        const float* xr = (r < RP) ? P.xp + (size_t)r * DM : P.xs + (size_t)(r - RP) * DM;
        const GAS f32x4* x4 = (const GAS f32x4*)xr + lane; const GAS f32x4* g4 = (const GAS f32x4*)P.gmix + lane;
        f32x4 v[4]; float s = 0.f;
#pragma unroll
        for (int j = 0; j < 4; ++j) { v[j] = x4[64 * j]; s += (v[j].x * v[j].x + v[j].y * v[j].y) + (v[j].z * v[j].z + v[j].w * v[j].w); }
        const float rinv = 1.0f / sqrtf(wave_sum(s) * (1.0f / DM) + RMS_EPS);
        GAS unsigned long long* o8 = (GAS unsigned long long*)(P.XN + (size_t)r * DM) + lane;
#pragma unroll
        for (int j = 0; j < 4; ++j) { const f32x4 gg = g4[64 * j]; const f32x4 y = v[j] * rinv * gg;
            o8[64 * j] = (unsigned long long)pk2(y.x, y.y) | ((unsigned long long)pk2(y.z, y.w) << 32); }
    }
    for (int it = gw; it < 16 * 12; it += NGW) {
        const int m = it / 12, cb = it % 12;
        { const float* mr = P.meta + (size_t)m * DM; float s = 0.f; float xv[16];
#pragma unroll
          for (int j = 0; j < 16; ++j) { xv[j] = mr[lane + 64 * j]; s += xv[j] * xv[j]; }
          const float rinv = 1.0f / sqrtf(wave_sum(s) * (1.0f / DM) + RMS_EPS);
#pragma unroll
          for (int j = 0; j < 16; ++j) scr[lane + 64 * j] = xv[j] * rinv * P.gmix[lane + 64 * j];
          LDS_WAIT(); asm volatile("" ::: "memory"); }
        const int col = 512 + cb * 64 + lane; const float* wp = P.win + col;
        float a = 0.f;
#pragma unroll 32
        for (int k = 0; k < DM; ++k) a += scr[k] * wp[(size_t)k * INW];
        LDS_WAIT(); asm volatile("" ::: "memory");
        if (cb < 2) {
            const float o = __shfl_xor(a, 8);
            if (lane < 16) { const float ang = (float)m * rope_invfreq(lane & 7); const float cs = cosf(ang), sn = sinf(ang); a = (lane < 8) ? a * cs - o * sn : a * cs + o * sn; }
            P.Km[m * 128 + cb * 64 + lane] = (bf16)f2bf(a);
        } else if (cb < 4) {
            P.Vm[m * 128 + (cb - 2) * 64 + lane] = (bf16)f2bf(a);
        } else {
            const bf16 ub = (bf16)f2bf(a);
            for (int sq = 0; sq < NBP + NBS; ++sq) P.U[(size_t)(useq_base(sq) + m) * 512 + (cb - 4) * 64 + lane] = ub;
        }
    }
    const int gt = (vcu * NWAVES + wave) * 64 + lane, NGT = G * NWAVES * 64;
    for (int e = gt; e < LS * 8; e += NGT) { const int pos = e >> 3, i = e & 7; const float ang = (float)pos * rope_invfreq(i); P.rope[pos * 16 + i] = cosf(ang); P.rope[pos * 16 + 8 + i] = sinf(ang); }
    for (int e = gt; e < LP; e += NGT) { const float t = 2.0f * (float)e / (float)LP; P.tabLP[e] = make_float2(cospif(t), sinpif(t)); }
    for (int e = gt; e < LS; e += NGT) { const float t = 2.0f * (float)e / (float)LS; P.tabLS[e] = make_float2(cospif(t), sinpif(t)); }
    for (int e = gt; e < N1P; e += NGT) { const float t = 2.0f * (float)e / (float)N1P; P.tabN1P[e] = make_float2(cospif(t), sinpif(t)); }
    for (int e = gt; e < N1S; e += NGT) { const float t = 2.0f * (float)e / (float)N1S; P.tabN1S[e] = make_float2(cospif(t), sinpif(t)); }
}

__device__ __forceinline__ void attn_key(const bf16* kr, const bf16* vr, bool valid, const float (&q)[64], float (&o)[64], float& m, float& l) {
    float s = 0.f;
#pragma unroll
    for (int c = 0; c < 8; ++c) { const v4u kk = *(const v4u*)(kr + 8 * c);
        s += q[8 * c + 0] * bflo(kk.x) + q[8 * c + 1] * bfhi(kk.x) + q[8 * c + 2] * bflo(kk.y) + q[8 * c + 3] * bfhi(kk.y)
           + q[8 * c + 4] * bflo(kk.z) + q[8 * c + 5] * bfhi(kk.z) + q[8 * c + 6] * bflo(kk.w) + q[8 * c + 7] * bfhi(kk.w); }
    if (!valid) s = -INFINITY;
    const float mn = fmaxf(m, s), a = __builtin_amdgcn_exp2f(m - mn), p = __builtin_amdgcn_exp2f(s - mn);
    l = l * a + p; m = mn;
#pragma unroll
    for (int c = 0; c < 8; ++c) { const v4u vv = *(const v4u*)(vr + 8 * c);
        o[8 * c + 0] = o[8 * c + 0] * a + p * bflo(vv.x); o[8 * c + 1] = o[8 * c + 1] * a + p * bfhi(vv.x);
        o[8 * c + 2] = o[8 * c + 2] * a + p * bflo(vv.y); o[8 * c + 3] = o[8 * c + 3] * a + p * bfhi(vv.y);
        o[8 * c + 4] = o[8 * c + 4] * a + p * bflo(vv.z); o[8 * c + 5] = o[8 * c + 5] * a + p * bfhi(vv.z);
        o[8 * c + 6] = o[8 * c + 6] * a + p * bflo(vv.w); o[8 * c + 7] = o[8 * c + 7] * a + p * bfhi(vv.w); }
}
__device__ __forceinline__ void attn_scalar(const Ptrs& P, int gw, int NGW, int lane) {
    for (int it = gw; it < 8 * (R / 64); it += NGW) {
        const int h = it & 7, tb = it >> 3, hk = h >> 2, r = tb * 64 + lane;
        int seq, s, S; row_decode(r, seq, s, S); const int rb = rseq_base(seq);
        float q[64], o[64];
#pragma unroll
        for (int c = 0; c < 8; ++c) { const v4u qq = *(const v4u*)(P.Q + (size_t)r * 512 + h * 64 + 8 * c);
            q[8 * c + 0] = bflo(qq.x); q[8 * c + 1] = bfhi(qq.x); q[8 * c + 2] = bflo(qq.y); q[8 * c + 3] = bfhi(qq.y);
            q[8 * c + 4] = bflo(qq.z); q[8 * c + 5] = bfhi(qq.z); q[8 * c + 6] = bflo(qq.w); q[8 * c + 7] = bfhi(qq.w); }
#pragma unroll
        for (int d = 0; d < 64; ++d) o[d] = 0.f;
        float m = P.sink[h] * LOG2E, l = 1.0f;
        for (int j = 0; j < NMETA; ++j) attn_key(P.Km + j * 128 + hk * 64, P.Vm + j * 128 + hk * 64, true, q, o, m, l);
        for (int dj = -WINDOW; dj <= WINDOW; ++dj) {
            const int sp = s + dj; const bool valid = (sp >= 0) && (sp < S); const int spc = sp < 0 ? 0 : (sp >= S ? S - 1 : sp);
            attn_key(P.K + (size_t)(rb + spc) * 128 + hk * 64, P.V + (size_t)(rb + spc) * 128 + hk * 64, valid, q, o, m, l);
        }
        const float il = 1.0f / l;
#pragma unroll
        for (int c = 0; c < 8; ++c) { v4u w; w.x = pk2(o[8 * c + 0] * il, o[8 * c + 1] * il); w.y = pk2(o[8 * c + 2] * il, o[8 * c + 3] * il); w.z = pk2(o[8 * c + 4] * il, o[8 * c + 5] * il); w.w = pk2(o[8 * c + 6] * il, o[8 * c + 7] * il);
            *(v4u*)(P.A + (size_t)r * 512 + h * 64 + 8 * c) = w; }
    }
}

template <int N1, int N2>
__device__ __forceinline__ void fft1_scalar(const bf16* U, bf16* Y, const float2* tab, int seq0, int nseq, int wg, int G, int tid) {
    for (int it = wg; it < nseq * N2; it += G) {
        const int seq = seq0 + it / N2, l2 = it % N2, col = tid;
        const bf16* ub = U + (size_t)useq_base(seq) * 512; bf16* yb = Y + (size_t)useq_base(seq) * 1024;
        float u[N1];
#pragma unroll
        for (int l1 = 0; l1 < N1; ++l1) u[l1] = bf2f(ub[(size_t)(l1 * N2 + l2) * 512 + col]);
        for (int k1 = 0; k1 < N1; ++k1) {
            float ar = 0.f, ai = 0.f; int idx = 0;
#pragma unroll
            for (int l1 = 0; l1 < N1; ++l1) { const float2 t = tab[idx]; ar += u[l1] * t.x; ai -= u[l1] * t.y; idx += k1; if (idx >= N1) idx -= N1; }
            yb[(size_t)((0 * N1 + k1) * N2 + l2) * 512 + col] = (bf16)f2bf(ar);
            yb[(size_t)((1 * N1 + k1) * N2 + l2) * 512 + col] = (bf16)f2bf(ai);
        }
    }
}
template <int N1, int N2>
__device__ __forceinline__ void fft2_scalar(const bf16* Y, bf16* AB, const float2* tab, int L, int seq0, int nseq, LAS unsigned char* lds, int wg, int G, int tid) {
    const float isl = 1.0f / sqrtf((float)L);
    for (int it = wg; it < nseq * N1 * 2; it += G) {
        const int half = it & 1, k1 = (it >> 1) % N1, seq = seq0 + (it >> 1) / N1;
        const bf16* yb = Y + (size_t)useq_base(seq) * 1024;
        for (int idx = tid; idx < 2 * N2 * 32; idx += NWAVES * 64) { const int row = idx >> 5, ch = idx & 31, ri = row / N2, l2 = row % N2;
            *(LAS v4u*)(lds + row * 512 + ch * 16) = *(const v4u*)(yb + (size_t)((ri * N1 + k1) * N2 + l2) * 512 + half * 256 + ch * 8); }
        __syncthreads();
        const int col = tid & 255, kh = __builtin_amdgcn_readfirstlane(tid >> 8);
        const LAS bf16* sl = (const LAS bf16*)lds;
        for (int k2 = kh * (N2 / 2); k2 < (kh + 1) * (N2 / 2); ++k2) {
            const int k = k1 + N1 * k2; float a = 0.f, b = 0.f; int ix = 0;
            for (int l2 = 0; l2 < N2; ++l2) { const float yr = bf2f(sl[l2 * 256 + col]), yi = bf2f(sl[(N2 + l2) * 256 + col]); const float2 t = tab[ix];
                a += yr * t.x + yi * t.y; b += yr * t.y - yi * t.x; ix += k; if (ix >= L) ix -= L; }
            if (k >= NMETA) { const size_t r = (size_t)(rseq_base(seq) + k - NMETA);
                AB[r * 1024 + half * 256 + col] = (bf16)f2bf(a * isl); AB[r * 1024 + 512 + half * 256 + col] = (bf16)f2bf(b * isl); }
        }
        __syncthreads();
    }
}

struct Args { const float* in[14]; float* out; unsigned char* ws; int ph_lo, ph_hi; };
__global__ void __launch_bounds__(NWAVES * 64, 2) mk_fwd(Args args) {
    extern __shared__ __attribute__((aligned(16))) unsigned char lds_raw[];
    LAS unsigned char* lds = (LAS unsigned char*)lds_raw;
    volatile LAS unsigned* MISC = (volatile LAS unsigned*)(lds + MISC_OFF);
    const int tid = threadIdx.x, lane = tid & 63, wave = __builtin_amdgcn_readfirstlane(tid >> 6);
    const int G = gridDim.x, bx = blockIdx.x, vcu = (G % 8 == 0) ? (bx % 8) * (G / 8) + bx / 8 : bx;
    unsigned char* ws = args.ws;
    gu32* ctl = (gu32*)(ws + WS_CTL);
    Ptrs P;
    P.xp = args.in[0]; P.xs = args.in[1]; P.meta = args.in[2]; P.gmix = args.in[3]; P.win = args.in[4]; P.bgate = args.in[5]; P.sink = args.in[6]; P.wao = args.in[7];
    P.wf = args.in[8]; P.wout = args.in[9]; P.gmlp = args.in[10]; P.wup = args.in[11]; P.wdn = args.in[12]; P.gfin = args.in[13]; P.out = args.out;
    P.WinT = (bf16*)(ws + WS_WIN); P.WaoT = (bf16*)(ws + WS_WAO); P.WfT = (bf16*)(ws + WS_WF); P.WoutT = (bf16*)(ws + WS_WOUT); P.WupT = (bf16*)(ws + WS_WUP); P.WdnT = (bf16*)(ws + WS_WDN);
    P.Gt = (bf16*)(ws + WS_G); P.Q = (bf16*)(ws + WS_Q); P.K = (bf16*)(ws + WS_K); P.V = (bf16*)(ws + WS_V); P.U = (bf16*)(ws + WS_U); P.A = (bf16*)(ws + WS_A);
    P.MG = (bf16*)(ws + WS_MERGED); P.TT = (bf16*)(ws + WS_TT); P.XN = (bf16*)(ws + WS_H); P.AB = (bf16*)(ws + WS_H); P.H1B = (bf16*)(ws + WS_H);
    P.Km = (bf16*)(ws + WS_KMETA); P.Vm = (bf16*)(ws + WS_VMETA); P.Y = (bf16*)args.out;
    P.ssq1 = (float*)(ws + WS_SSQ1); P.rope = (float*)(ws + WS_ROPE);
    P.tabLP = (float2*)(ws + WS_TABLP); P.tabLS = (float2*)(ws + WS_TABLS); P.tabN1P = (float2*)(ws + WS_TABN1P); P.tabN1S = (float2*)(ws + WS_TABN1S);

    for (int u = tid; u < (LDS_BYTES - LDSCTL_OFF) / 4; u += NWAVES * 64) ((LAS unsigned*)(lds + LDSCTL_OFF))[u] = 0u;
    __syncthreads();
    XcdBarrier bar; bar.bar = (unsigned*)(ctl + CW_BAR); bar.x = 0; bar.st = nullptr;
    if (MK_N_LAUNCHES == 1) bar = xcd_barrier_post((unsigned*)(ctl + CW_BAR), MISC + 8);
    const int lo = args.ph_lo, hi = args.ph_hi;
#define IN(k) (lo <= (k) && (k) < hi)
#define SEAM(k) do { if (IN(k) && IN((k) + 1)) xcd_barrier(bar); } while (0)
    const int gw = vcu * NWAVES + wave, NGW = G * NWAVES;

    if (IN(0)) { p0_prologue(P, lds, vcu, G, tid, lane, wave); SEAM(0); }
    if (IN(1)) {
        pg8::Gemm g{P.XN, P.WinT, R, INW, DM}; pg8::StaticOrder S; S.init(R, INW, G, bx);
        EpiIn E{P.Q, P.K, P.V, P.U, P.Gt, P.bgate, P.rope};
        pg8::gemm_phase<EpiIn, pg8::StaticOrder, true, true>(lds, g, S, E);
        SEAM(1);
    }
    if (IN(2)) {
        attn_scalar(P, gw, NGW, lane);
        fft1_scalar<N1P, N2P>(P.U, P.Y, P.tabN1P, 0, NBP, vcu, G, tid);
        fft1_scalar<N1S, N2S>(P.U, P.Y, P.tabN1S, NBP, NBS, vcu, G, tid);
        SEAM(2);
    }
    if (IN(3)) {
        fft2_scalar<N1P, N2P>(P.Y, P.AB, P.tabLP, LP, 0, NBP, lds, vcu, G, tid);
        fft2_scalar<N1S, N2S>(P.Y, P.AB, P.tabLS, LS, NBP, NBS, lds, vcu, G, tid);
        SEAM(3);
    }
    if (IN(4)) {
        pg8::Gemm g{P.A, P.WaoT, R, DM, 512}; pg8::StaticOrder S; S.init(R, DM, G, bx);
        EpiAO E{P.Gt, P.out};
        pg8::gemm_phase<EpiAO, pg8::StaticOrder, true, true>(lds, g, S, E);
        SEAM(4);
    }
    if (IN(5)) {
        pg8::Gemm g{P.AB, P.WfT, R, DM, DM}; pg8::StaticOrder S; S.init(R, DM, G, bx);
        EpiF E{P.Gt, P.out, P.MG};
        pg8::gemm_phase<EpiF, pg8::StaticOrder, true, true>(lds, g, S, E);
        SEAM(5);
    }
    if (IN(6)) {
        pg8::Gemm g{P.MG, P.WoutT, R, DM, DM}; pg8::StaticOrder S; S.init(R, DM, G, bx);
        EpiOut E{P.xp, P.xs, P.out, P.H1B, P.ssq1};
        pg8::gemm_phase<EpiOut, pg8::StaticOrder, true, true>(lds, g, S, E);
        SEAM(6);
    }
    if (IN(7)) {
        pg8::Gemm g{P.H1B, P.WupT, R, FFD, DM}; pg8::StaticOrder S; S.init(R, FFD, G, bx);
        EpiUp E{P.ssq1, P.TT};
        pg8::gemm_phase<EpiUp, pg8::StaticOrder, true, true>(lds, g, S, E);
        SEAM(7);
    }
    if (IN(8)) {
        pg8::Gemm g{P.TT, P.WdnT, R, DM, FFD}; pg8::StaticOrder S; S.init(R, DM, G, bx);
        EpiDown E{P.out};
        pg8::gemm_phase<EpiDown, pg8::StaticOrder, true, true>(lds, g, S, E);
        SEAM(8);
    }
    if (IN(9)) {
        for (int r = gw; r < R; r += NGW) {
            GAS f32x4* h4 = (GAS f32x4*)(P.out + (size_t)r * DM) + lane; const GAS f32x4* g4 = (const GAS f32x4*)P.gfin + lane;
            f32x4 v[4]; float s = 0.f;
#pragma unroll
            for (int j = 0; j < 4; ++j) { v[j] = h4[64 * j]; s += (v[j].x * v[j].x + v[j].y * v[j].y) + (v[j].z * v[j].z + v[j].w * v[j].w); }
            const float rinv = 1.0f / sqrtf(wave_sum(s) * (1.0f / DM) + RMS_EPS);
#pragma unroll
            for (int j = 0; j < 4; ++j) h4[64 * j] = v[j] * rinv * g4[64 * j];
        }
    }
#undef IN
#undef SEAM
}

extern "C" void kernel_launch(void* const* d_in, const int* in_sizes, int n_in, void* d_out, int out_size, void* d_ws, size_t ws_size, hipStream_t stream) {
    static int grid = 0;
    if (grid == 0) {
        if (n_in != 14 || in_sizes[0] != RP * DM || in_sizes[1] != RS * DM || out_size != R * DM || ws_size < WS_END) {
            fprintf(stderr, "kernel_launch: unexpected shapes: n_in %d in0 %d in1 %d out %d ws %zu (need >= %zu); nothing launched\n", n_in, n_in > 0 ? in_sizes[0] : -1, n_in > 1 ? in_sizes[1] : -1, out_size, ws_size, (size_t)WS_END);
            grid = -1; return; }
        int dev = 0, cus = 0;
        if (hipGetDevice(&dev) != hipSuccess || hipDeviceGetAttribute(&cus, hipDeviceAttributeMultiprocessorCount, dev) != hipSuccess) { grid = -1; return; }
        if (hipFuncSetAttribute((const void*)mk_fwd, hipFuncAttributeMaxDynamicSharedMemorySize, LDS_BYTES) != hipSuccess) { fprintf(stderr, "kernel_launch: hipFuncSetAttribute failed\n"); grid = -1; return; }
        int per_cu = 0;
        if (hipOccupancyMaxActiveBlocksPerMultiprocessor(&per_cu, (const void*)mk_fwd, NWAVES * 64, LDS_BYTES) != hipSuccess || per_cu < 1)
            fprintf(stderr, "kernel_launch: note: occupancy query reports %d workgroups per CU\n", per_cu);
        (void)hipGetLastError();
        grid = cus;
    }
    if (grid < 0) return;
    if (hipMemsetAsync((char*)d_ws + WS_CTL, 0, CTL_ZERO_BYTES, stream) != hipSuccess) { fprintf(stderr, "kernel_launch: memset failed\n"); return; }
    Args a{};
    for (int i = 0; i < 14; ++i) a.in[i] = (const float*)d_in[i];
    a.out = (float*)d_out; a.ws = (unsigned char*)d_ws;
    if (MK_N_LAUNCHES == 1) { a.ph_lo = 0; a.ph_hi = N_PHASES; hipLaunchKernelGGL(mk_fwd, dim3(grid), dim3(NWAVES * 64), LDS_BYTES, stream, a); }
    else for (int p = 0; p < N_PHASES; ++p) { a.ph_lo = p; a.ph_hi = p + 1; hipLaunchKernelGGL(mk_fwd, dim3(grid), dim3(NWAVES * 64), LDS_BYTES, stream, a); }
    const hipError_t le = hipPeekAtLastError();
    if (le != hipSuccess) fprintf(stderr, "kernel_launch: launch failed: %s\n", hipGetErrorName(le));
}
```

```cpp
#include <hip/hip_runtime.h>
#include <cstdio>
#include <cstdint>
#include <cmath>
namespace pg8 {
#define PG8_LAS __attribute__((address_space(3)))
typedef unsigned short bf16_t;
typedef short bf16x8 __attribute__((ext_vector_type(8)));
typedef float f32x4 __attribute__((ext_vector_type(4)));
typedef unsigned u32x4 __attribute__((ext_vector_type(4)));
constexpr int BM = 256, BK = 64, HALF = 128, HTB = HALF * BK * 2  , STAGE_BYTES = 8 * HTB, NXCD = 8, WGM = 8;

__host__ __device__ __forceinline__ int lds_byte(int r, int c) { const int st = (r >> 4) * 2 + (c >> 5), rr = r & 15, cc = c & 31, ob = rr * 64 + cc * 2; return st * 1024 + (ob ^ (((ob >> 9) & 1) << 5)); }
__host__ __device__ __forceinline__ void stage_rc(int b, int& R, int& C) { const int st = b / 1024, sb = b % 1024, swz = sb ^ (((sb >> 9) & 1) << 5); R = (st >> 1) * 16 + swz / 64; C = (st & 1) * 32 + (swz % 64) / 2; }
__host__ __device__ __forceinline__ int perm32(int rho) { const int n = rho >> 4, i = rho & 15; return 8 * (i >> 2) + 4 * n + (i & 3); }

struct Unit { int pm, pn; };
struct Gemm { const bf16_t* A; const bf16_t* Bt; int M, N, K; };

struct StaticOrder {
    int nM, nN, nwg, G, c;
    __host__ __device__ void init(int M, int N, int G_, int c_) { nM = M / BM; nN = N / BM; nwg = nM * nN; G = G_; c = c_; }
    __host__ __device__ bool next(int i, Unit& u) const {
        const long L = (long)i * G + c; if (L >= nwg) return false;
        int wgid = (int)L; { const int q = nwg / NXCD, r = nwg % NXCD, xcd = wgid % NXCD, off = wgid / NXCD; wgid = (xcd < r ? xcd * (q + 1) : r * (q + 1) + (xcd - r) * q) + off; }
        const int nig = WGM * nN, gid = wgid / nig, fm = gid * WGM, gsz = (nM - fm) < WGM ? (nM - fm) : WGM;
        u.pm = fm + ((wgid % nig) % gsz); u.pn = (wgid % nig) / gsz; return true;
    }
    __device__ __forceinline__ void a_ready(const Unit&) const {}
    __device__ __forceinline__ void done(const Unit&) const {}
};

__device__ __forceinline__ unsigned cvt_pk_bf16(float lo, float hi) { unsigned r; asm volatile("v_cvt_pk_bf16_f32 %0, %1, %2" : "=v"(r) : "v"(lo), "v"(hi)); return r; }
typedef float f32x2 __attribute__((ext_vector_type(2)));
template <class Epi, class Sched, bool ALIGN_EPI = false, bool SP2 = false>
__device__ __forceinline__ void gemm_phase(PG8_LAS unsigned char* lds, const Gemm g, const Sched& S, const Epi& E) {
    const int tid = threadIdx.x, wid = __builtin_amdgcn_readfirstlane(tid >> 6), lane = tid & 63, wr = wid >> 2, wc = wid & 3, fr = lane & 15, fq = lane >> 4;
    const int K = g.K, nt = K / BK;
    unsigned voffA[2], voffB[2];
#pragma unroll
    for (int i = 0; i < 2; ++i) { int R, C; stage_rc(tid * 16 + i * 8192, R, C); const int Rb = Epi::PERM ? ((R & ~31) + perm32(R & 31)) : R;
        voffA[i] = (unsigned)(R * K + C) * 2u; voffB[i] = (unsigned)(Rb * K + C) * 2u; }
    const size_t kstep = (size_t)(BK * 2);
    const size_t hstep = (size_t)HALF * K * 2;
    const size_t tstep = 2 * hstep;
    const unsigned ldsw = (unsigned)wid * 1024u;
    const int aoff = lds_byte(wr * 64 + fr, fq * 8), boff = lds_byte(wc * 32 + fr, fq * 8);
#define PG8_SA(b, h) (((b) * 2 + (h)) * HTB)
#define PG8_SB(b, h) ((4 + (b) * 2 + (h)) * HTB)
#define PG8_STAGE(bufoff, gbase, voff) do { _Pragma("unroll") for (int _i = 0; _i < 2; ++_i) \
        __builtin_amdgcn_global_load_lds((const unsigned*)((const char*)(gbase) + (voff)[_i]), (PG8_LAS unsigned*)(lds + (bufoff) + ldsw + _i * 8192), 16, 0, 0); } while (0)
#define PG8_LDA(dst, b, h) do { _Pragma("unroll") for (int m = 0; m < 4; ++m) _Pragma("unroll") for (int k = 0; k < 2; ++k) dst[m][k] = *(const PG8_LAS bf16x8*)(lds + PG8_SA(b, h) + aoff + m * 2048 + k * 1024); } while (0)
#define PG8_LDB(dst, b, h) do { _Pragma("unroll") for (int n = 0; n < 2; ++n) _Pragma("unroll") for (int k = 0; k < 2; ++k) dst[n][k] = *(const PG8_LAS bf16x8*)(lds + PG8_SB(b, h) + boff + n * 2048 + k * 1024); } while (0)
#define PG8_MMA(ai, bj, At, Bt) do { __builtin_amdgcn_s_setprio(1); _Pragma("unroll") for (int m = 0; m < 4; ++m) _Pragma("unroll") for (int n = 0; n < 2; ++n) _Pragma("unroll") for (int k = 0; k < 2; ++k) \
        acc[ai][bj][m][n] = __builtin_amdgcn_mfma_f32_16x16x32_bf16(Bt[n][k], At[m][k], acc[ai][bj][m][n], 0, 0, 0); __builtin_amdgcn_s_setprio(0); } while (0)
#define PG8_WAIT_V(n) asm volatile("s_waitcnt vmcnt(" #n ")" ::: "memory")
#define PG8_WAIT_L(n) asm volatile("s_waitcnt lgkmcnt(" #n ")" ::: "memory")
#define PG8_BAR __builtin_amdgcn_s_barrier()
#define PG8_SCHED __builtin_amdgcn_sched_barrier(0)
    Unit cur, nxt; int ui = 0;
    if (!S.next(0, cur)) return;
    f32x4 acc[2][2][4][2];
#pragma unroll
    for (int a = 0; a < 2; ++a)
#pragma unroll
        for (int b = 0; b < 2; ++b)
#pragma unroll
            for (int m = 0; m < 4; ++m)
#pragma unroll
                for (int n = 0; n < 2; ++n) acc[a][b][m][n] = (f32x4){0.f, 0.f, 0.f, 0.f};
    bf16x8 At[4][2], B0[2][2], B1[2][2];
    const char* cA = (const char*)g.A + (size_t)cur.pm * tstep; const char* cB = (const char*)g.Bt + (size_t)cur.pn * tstep;
    S.a_ready(cur);
    if constexpr (SP2) {
        PG8_STAGE(PG8_SB(0, 0), cB, voffB); PG8_STAGE(PG8_SB(0, 1), cB + hstep, voffB); PG8_STAGE(PG8_SA(0, 0), cA, voffA); PG8_STAGE(PG8_SA(0, 1), cA + hstep, voffA);
        if (wr == 1) PG8_BAR;
        PG8_WAIT_V(2); PG8_BAR;
        PG8_STAGE(PG8_SB(1, 0), cB + kstep, voffB); PG8_STAGE(PG8_SA(1, 0), cA + kstep, voffA); PG8_STAGE(PG8_SB(1, 1), cB + hstep + kstep, voffB);
        PG8_WAIT_V(6); PG8_BAR;
    } else {
        PG8_STAGE(PG8_SB(0, 0), cB, voffB); PG8_STAGE(PG8_SA(0, 0), cA, voffA); PG8_STAGE(PG8_SB(0, 1), cB + hstep, voffB); PG8_STAGE(PG8_SA(0, 1), cA + hstep, voffA);
        if (wr == 1) PG8_BAR;
        PG8_WAIT_V(4); PG8_BAR;
        PG8_STAGE(PG8_SB(1, 0), cB + kstep, voffB); PG8_STAGE(PG8_SA(1, 0), cA + kstep, voffA); PG8_STAGE(PG8_SB(1, 1), cB + hstep + kstep, voffB);
        PG8_WAIT_V(6); PG8_BAR;
    }
    for (;;) {
        const bool has_next = S.next(ui + 1, nxt);
        const char* nA = has_next ? (const char*)g.A + (size_t)nxt.pm * tstep : cA; const char* nB = has_next ? (const char*)g.Bt + (size_t)nxt.pn * tstep : cB;
        for (int t = 0; t < nt; t += 2) {
            const bool last = (t == nt - 2);
            const char* a1 = cA + (size_t)(t + 1) * kstep;
            const char* a2 = last ? nA : cA + (size_t)(t + 2) * kstep; const char* b2 = last ? nB : cB + (size_t)(t + 2) * kstep;
            const char* a3 = a2 + kstep; const char* b3 = b2 + kstep;
            if (last && has_next) S.a_ready(nxt);
            if constexpr (SP2) {
            PG8_LDB(B0, 0, 0); PG8_LDB(B1, 0, 1); PG8_SCHED; PG8_LDA(At, 0, 0); PG8_STAGE(PG8_SA(1, 1), a1 + hstep, voffA);
            PG8_WAIT_V(8); PG8_WAIT_L(0); PG8_BAR; PG8_MMA(0, 0, At, B0); PG8_MMA(0, 1, At, B1); PG8_BAR; PG8_SCHED;
            PG8_LDA(At, 0, 1); PG8_STAGE(PG8_SB(0, 0), b2, voffB); PG8_STAGE(PG8_SB(0, 1), b2 + hstep, voffB); PG8_STAGE(PG8_SA(0, 0), a2, voffA);
            PG8_WAIT_V(8); PG8_WAIT_L(0); PG8_BAR; PG8_MMA(1, 0, At, B0); PG8_MMA(1, 1, At, B1); PG8_BAR; PG8_SCHED;
            PG8_LDB(B0, 1, 0); PG8_LDB(B1, 1, 1); PG8_SCHED; PG8_LDA(At, 1, 0); PG8_STAGE(PG8_SA(0, 1), a2 + hstep, voffA);
            PG8_WAIT_V(8); PG8_WAIT_L(0); PG8_BAR; PG8_MMA(0, 0, At, B0); PG8_MMA(0, 1, At, B1); PG8_BAR; PG8_SCHED;
            PG8_LDA(At, 1, 1); PG8_STAGE(PG8_SB(1, 0), b3, voffB); PG8_STAGE(PG8_SB(1, 1), b3 + hstep, voffB); PG8_STAGE(PG8_SA(1, 0), a3, voffA);
            PG8_WAIT_V(8); PG8_WAIT_L(0); PG8_BAR; PG8_MMA(1, 0, At, B0); PG8_MMA(1, 1, At, B1); PG8_BAR; PG8_SCHED;
            } else {
            PG8_LDB(B0, 0, 0); PG8_SCHED; PG8_LDA(At, 0, 0); PG8_STAGE(PG8_SA(1, 1), a1 + hstep, voffA);
            PG8_WAIT_L(8); PG8_BAR; PG8_WAIT_L(0); PG8_MMA(0, 0, At, B0); PG8_BAR; PG8_SCHED;
            PG8_LDB(B1, 0, 1); PG8_STAGE(PG8_SB(0, 0), b2, voffB);
            PG8_BAR; PG8_WAIT_L(0); PG8_MMA(0, 1, At, B1); PG8_BAR;
            PG8_LDA(At, 0, 1); PG8_STAGE(PG8_SA(0, 0), a2, voffA);
            PG8_BAR; PG8_WAIT_L(0); PG8_MMA(1, 0, At, B0); PG8_BAR; PG8_SCHED;
            PG8_STAGE(PG8_SB(0, 1), b2 + hstep, voffB);
            PG8_WAIT_V(6); PG8_BAR; PG8_MMA(1, 1, At, B1); PG8_BAR;
            PG8_LDB(B0, 1, 0); PG8_SCHED; PG8_LDA(At, 1, 0); PG8_STAGE(PG8_SA(0, 1), a2 + hstep, voffA);
            PG8_WAIT_L(8); PG8_BAR; PG8_WAIT_L(0); PG8_MMA(0, 0, At, B0); PG8_BAR; PG8_SCHED;
            PG8_LDB(B1, 1, 1); PG8_STAGE(PG8_SB(1, 0), b3, voffB);
            PG8_BAR; PG8_WAIT_L(0); PG8_MMA(0, 1, At, B1); PG8_BAR;
            PG8_LDA(At, 1, 1); PG8_STAGE(PG8_SA(1, 0), a3, voffA);
            PG8_BAR; PG8_WAIT_L(0); PG8_MMA(1, 0, At, B0); PG8_BAR; PG8_SCHED;
            PG8_STAGE(PG8_SB(1, 1), b3 + hstep, voffB);
            PG8_WAIT_V(6); PG8_BAR; PG8_MMA(1, 1, At, B1); PG8_BAR;
            }
        }
        if constexpr (ALIGN_EPI) { if (wr == 0) PG8_BAR; }
        if constexpr (!Epi::AFTER_DRAIN) { E(acc, cur, wr, wc, fr, fq); S.done(cur); }
        if (!has_next) break;
#pragma unroll
        for (int a = 0; a < 2; ++a)
#pragma unroll
            for (int b = 0; b < 2; ++b)
#pragma unroll
                for (int m = 0; m < 4; ++m)
#pragma unroll
                    for (int n = 0; n < 2; ++n) acc[a][b][m][n] = (f32x4){0.f, 0.f, 0.f, 0.f};
        cur = nxt; cA = nA; cB = nB; ++ui;
        if constexpr (ALIGN_EPI) { if (wr == 1) PG8_BAR; }
    }
    PG8_WAIT_V(0);
    if constexpr (!ALIGN_EPI) { if (wr == 0) PG8_BAR; }
    PG8_BAR;
    if constexpr (Epi::AFTER_DRAIN) { E.fused(acc, cur, wr, wc, fr, fq, lds, wid, lane); S.done(cur); }
#undef PG8_SA
#undef PG8_SB
#undef PG8_STAGE
#undef PG8_LDA
#undef PG8_LDB
#undef PG8_MMA
#undef PG8_WAIT_V
#undef PG8_WAIT_L
#undef PG8_BAR
#undef PG8_SCHED
}
}

#define GAS __attribute__((address_space(1)))
#define LAS __attribute__((address_space(3)))
typedef unsigned short bf16;
typedef unsigned v4u __attribute__((ext_vector_type(4)));
typedef float f32x4 __attribute__((ext_vector_type(4)));
typedef short bf16x8 __attribute__((ext_vector_type(8)));
typedef GAS unsigned gu32;
typedef GAS unsigned long long gu64;
#define RLX_AGENT __ATOMIC_RELAXED, __HIP_MEMORY_SCOPE_AGENT
#define LDS_WAIT() asm volatile("s_waitcnt lgkmcnt(0)" ::: "memory")
#define VM_WAIT() asm volatile("s_waitcnt vmcnt(0)" ::: "memory")
__device__ __forceinline__ unsigned long long rt() { return __builtin_amdgcn_s_memrealtime(); }
__device__ __forceinline__ unsigned f2bf(float f) { unsigned u = __builtin_bit_cast(unsigned, f); return (u + 0x7fffu + ((u >> 16) & 1u)) >> 16; }
__device__ __forceinline__ unsigned pk2(float lo, float hi) { return f2bf(lo) | (f2bf(hi) << 16); }
#define XB_TMO      128
#define XB_XCNT(j)  (256  + 64 * (j))
#define XB_XSUB(j)  (1280 + 64 * (j))
#define XB_XGEN(j)  (2304 + 64 * (j))
#define XB_TOP      3328
#define XB_TOPGEN   3392
#define XCD_BAR_WORDS 3456
#define XB_SPIN_CAP (1u << 18)

__device__ __forceinline__ unsigned xb_ld(unsigned* p)              { return __hip_atomic_load(p, __ATOMIC_RELAXED, __HIP_MEMORY_SCOPE_AGENT); }
__device__ __forceinline__ unsigned xb_add(unsigned* p, unsigned v) { return __hip_atomic_fetch_add(p, v, __ATOMIC_RELAXED, __HIP_MEMORY_SCOPE_AGENT); }
__device__ __forceinline__ unsigned xb_xcc_id() { return (unsigned)__builtin_amdgcn_s_getreg((3 << 11) | 20) & 0xFu; }
#define XB_SPIN(cond, bar) do { unsigned _sp = 0; while (cond) { __builtin_amdgcn_s_sleep(1); \
    if ((++_sp & 255u) == 0u) { if (xb_ld(&(bar)[XB_TMO])) break; if (_sp > XB_SPIN_CAP) { atomicAdd(&(bar)[XB_TMO], 1u); break; } } } } while (0)

struct XcdBarrier {
    unsigned* bar; unsigned x;
    volatile LAS unsigned* st;
};

__device__ __forceinline__ XcdBarrier xcd_barrier_post(unsigned* bar, volatile LAS unsigned* st) {
    XcdBarrier b; b.bar = bar; b.x = xb_xcc_id(); b.st = st;
    if (threadIdx.x == 0) (void)xb_add(&bar[XB_XCNT(b.x)], 1u);
    return b;
}
__device__ __forceinline__ void xcd_barrier_complete(unsigned* bar, unsigned x, unsigned& nloc, unsigned& nx) {
    const unsigned G = gridDim.x * gridDim.y * gridDim.z;
    unsigned sum, cnt, mine, sp = 0u;
    for (;;) {
        sum = 0u; cnt = 0u; mine = 0u;
#pragma unroll
        for (unsigned j = 0; j < 16; ++j) { const unsigned c = xb_ld(&bar[XB_XCNT(j)]); sum += c; cnt += (c > 0u) ? 1u : 0u; mine = (j == x) ? c : mine; }
        if (sum == G) break;
        __builtin_amdgcn_s_sleep(1);
        if ((++sp & 255u) == 0u) { if (xb_ld(&bar[XB_TMO])) break; if (sp > XB_SPIN_CAP) { atomicAdd(&bar[XB_TMO], 1u); break; } }
    }
    nloc = mine > 0u ? mine : 1u; nx = cnt > 0u ? cnt : 1u;
}

__device__ __forceinline__ void xcd_barrier(const XcdBarrier& b) {
    asm volatile("s_waitcnt vmcnt(0)" ::: "memory");
    __syncthreads();
    if (threadIdx.x == 0) {
        unsigned* bar = b.bar;
        __builtin_amdgcn_s_waitcnt(0);
        unsigned nloc = b.st[0], nx = b.st[1];
        if (nloc == 0u) { xcd_barrier_complete(bar, b.x, nloc, nx); b.st[0] = nloc; b.st[1] = nx; }
        const unsigned old = xb_add(&bar[XB_XSUB(b.x)], 1u);
        const unsigned gen = old / nloc;
        if (old + 1u == (gen + 1u) * nloc) {
            __builtin_amdgcn_fence(__ATOMIC_RELEASE, "agent");
            asm volatile("s_waitcnt vmcnt(0)" ::: "memory");
            const unsigned og = xb_add(&bar[XB_TOP], 1u);
            const unsigned tg = og / nx;
            if (og + 1u == (tg + 1u) * nx) xb_add(&bar[XB_TOPGEN], 1u);
            else XB_SPIN(xb_ld(&bar[XB_TOPGEN]) == tg, bar);
            __builtin_amdgcn_fence(__ATOMIC_ACQUIRE, "agent");
            xb_add(&bar[XB_XGEN(b.x)], 1u);
            asm volatile("s_waitcnt vmcnt(0)" ::: "memory");
        } else {
            XB_SPIN(xb_ld(&bar[XB_XGEN(b.x)]) == gen, bar);
            __builtin_amdgcn_fence(__ATOMIC_ACQUIRE, "agent");
            asm volatile("s_waitcnt vmcnt(0)" ::: "memory");
        }
    }
    __syncthreads();
}


constexpr int DM = 1024, FFD = 4096, INW = 3328;
constexpr int SEQP = 2048, SEQS = 8192, NBP = 16, NBS = 2;
constexpr int RP = NBP * SEQP, RS = NBS * SEQS, R = RP + RS;
constexpr int NMETA = 16, LP = SEQP + NMETA, LS = SEQS + NMETA;
constexpr int N1P = 43, N2P = 48, N1S = 76, N2S = 108;
constexpr int UROWS = NBP * LP + NBS * LS;
constexpr float RMS_EPS = 1e-6f, LOG2E = 1.4426950408889634f, QSCALE = 0.125f * 1.4426950408889634f;
constexpr int WINDOW = 128;
#ifndef MK_N_LAUNCHES
#define MK_N_LAUNCHES 1
#endif
constexpr int N_PHASES = 10;

constexpr size_t MiB = 1u << 20;
constexpr size_t WS_CTL = 0, CTL_ZERO_BYTES = 1 * MiB;
constexpr size_t WS_WIN = 2 * MiB, WS_WAO = 9 * MiB, WS_WF = 10 * MiB, WS_WOUT = 12 * MiB, WS_WUP = 14 * MiB, WS_WDN = 22 * MiB;
constexpr size_t WS_SSQ1 = 2 * MiB;
constexpr size_t WS_ROPE = 30 * MiB;
constexpr size_t WS_TABLP = 30 * MiB + 640 * 1024, WS_TABLS = WS_TABLP + 32 * 1024, WS_TABN1P = WS_TABLP + 128 * 1024, WS_TABN1S = WS_TABLP + 132 * 1024;
constexpr size_t WS_KMETA = 31 * MiB, WS_VMETA = 31 * MiB + 4096;
constexpr size_t WS_G = 32 * MiB, WS_Q = 224 * MiB, WS_K = 272 * MiB, WS_V = 284 * MiB, WS_U = 296 * MiB, WS_A = 345 * MiB;
constexpr size_t WS_MERGED = 224 * MiB;
constexpr size_t WS_TT = 32 * MiB;
constexpr size_t WS_H = 416 * MiB;
constexpr size_t WS_END = 512 * MiB;
static_assert(WS_U + (size_t)UROWS * 512 * 2 <= WS_A && WS_A + (size_t)R * 512 * 2 <= WS_H && WS_TT + (size_t)R * FFD * 2 <= WS_H && WS_H + (size_t)R * DM * 2 <= WS_END, "d_ws map");
static_assert(WS_WIN + (size_t)INW * DM * 2 <= WS_WAO && WS_SSQ1 + (size_t)R * 16 * 4 <= WS_WAO, "d_ws map (weights)");
constexpr int CW_BAR = 4096;

constexpr int RING_BYTES = 131072, LDSCTL_OFF = RING_BYTES, MISC_OFF = LDSCTL_OFF + 320, TAB128_OFF = LDSCTL_OFF + 1024, LDS_BYTES = 147456;
constexpr int NWAVES = 8;

__device__ __forceinline__ float bf2f(unsigned short b) { return __builtin_bit_cast(float, (unsigned)b << 16); }
__device__ __forceinline__ float bflo(unsigned u) { return __builtin_bit_cast(float, u << 16); }
__device__ __forceinline__ float bfhi(unsigned u) { return __builtin_bit_cast(float, u & 0xffff0000u); }
__device__ __forceinline__ float wave_sum(float v) {
#pragma unroll
    for (int o = 1; o < 64; o <<= 1) v += __shfl_xor(v, o);
    return v;
}
__device__ __forceinline__ void row_decode(int r, int& seq, int& s, int& S) {
    if (r < RP) { seq = r >> 11; s = r & (SEQP - 1); S = SEQP; } else { const int q = r - RP; seq = NBP + (q >> 13); s = q & (SEQS - 1); S = SEQS; }
}
__device__ __forceinline__ int useq_base(int seq) { return seq < NBP ? seq * LP : NBP * LP + (seq - NBP) * LS; }
__device__ __forceinline__ int rseq_base(int seq) { return seq < NBP ? seq * SEQP : RP + (seq - NBP) * SEQS; }
__device__ __forceinline__ float sigmoidf_fast(float x) { return __builtin_amdgcn_rcpf(1.0f + __builtin_amdgcn_exp2f(-x * LOG2E)); }

typedef pg8::u32x4 u32x4; using pg8::Unit; typedef pg8::bf16_t bf16_t; using pg8::cvt_pk_bf16;
__device__ __forceinline__ u32x4 pack8(const f32x4 a, const f32x4 b) { u32x4 w; w.x = cvt_pk_bf16(a[0], a[1]); w.y = cvt_pk_bf16(a[2], a[3]); w.z = cvt_pk_bf16(b[0], b[1]); w.w = cvt_pk_bf16(b[2], b[3]); return w; }

struct EpiIn {
    static constexpr bool PERM = true, AFTER_DRAIN = false;
    bf16_t *Q, *K, *V, *U, *G; const float* bgate; const float* rope;
    __device__ __forceinline__ void operator()(const f32x4 (&acc)[2][2][4][2], const Unit& u, int wr, int wc, int fr, int fq) const {
        const int pn = u.pn, rowt = u.pm * 256;
        int seq, s0, S; row_decode(rowt, seq, s0, S);
        const int ub = useq_base(seq) + NMETA + s0 - rowt;
        const int lane = fr + 16 * fq;
#pragma unroll
        for (int ai = 0; ai < 2; ++ai)
#pragma unroll
            for (int m = 0; m < 4; ++m) {
                const int rl = ai * 128 + wr * 64 + m * 16 + fr, row = rowt + rl;
#pragma unroll
                for (int bj = 0; bj < 2; ++bj) {
                    f32x4 v0 = acc[ai][bj][m][0], v1 = acc[ai][bj][m][1];
                    const int cc = bj * 128 + wc * 32 + 8 * fq;
                    if (pn < 3 && !(pn == 2 && bj == 1)) {
                        if ((wc & 1) == 0) {
                            f32x4 o0, o1;
#pragma unroll
                            for (int j = 0; j < 4; ++j) { o0[j] = __shfl_xor(v0[j], 16); o1[j] = __shfl_xor(v1[j], 16); }
                            if (fq < 2) {
                                const float* rp = rope + (size_t)(NMETA + s0 + rl) * 16;
                                const f32x4 c0 = *(const f32x4*)(rp), c1 = *(const f32x4*)(rp + 4), s0v = *(const f32x4*)(rp + 8), s1v = *(const f32x4*)(rp + 12);
                                const float sg = (fq == 0) ? -1.f : 1.f;
                                v0 = v0 * c0 + (o0 * s0v) * sg; v1 = v1 * c1 + (o1 * s1v) * sg;
                            }
                        }
                        if (pn < 2) { v0 = v0 * QSCALE; v1 = v1 * QSCALE; *(u32x4*)(Q + (size_t)row * 512 + pn * 256 + cc) = pack8(v0, v1); }
                        else *(u32x4*)(K + (size_t)row * 128 + cc) = pack8(v0, v1);
                    } else if (pn == 2) {
                        *(u32x4*)(V + (size_t)row * 128 + (cc - 128)) = pack8(v0, v1);
                    } else if (pn < 5) {
                        *(u32x4*)(U + (size_t)(ub + row) * 512 + (pn - 3) * 256 + cc) = pack8(v0, v1);
                    } else {
                        const int gc = (pn - 5) * 256 + cc;
                        const f32x4 b0 = *(const f32x4*)(bgate + gc), b1 = *(const f32x4*)(bgate + gc + 4);
#pragma unroll
                        for (int j = 0; j < 4; ++j) { v0[j] = sigmoidf_fast(v0[j] + b0[j]); v1[j] = sigmoidf_fast(v1[j] + b1[j]); }
                        *(u32x4*)(G + (size_t)row * 2048 + gc) = pack8(v0, v1);
                    }
                }
            }
        (void)lane;
    }
};
struct EpiAO {
    static constexpr bool PERM = true, AFTER_DRAIN = false;
    const bf16_t* G; float* tmp;
    __device__ __forceinline__ void operator()(const f32x4 (&acc)[2][2][4][2], const Unit& u, int wr, int wc, int fr, int fq) const {
#pragma unroll
        for (int ai = 0; ai < 2; ++ai)
#pragma unroll
            for (int m = 0; m < 4; ++m) {
                const int row = u.pm * 256 + ai * 128 + wr * 64 + m * 16 + fr;
#pragma unroll
                for (int bj = 0; bj < 2; ++bj) {
                    const int col = u.pn * 256 + bj * 128 + wc * 32 + 8 * fq;
                    const u32x4 g = *(const u32x4*)(G + (size_t)row * 2048 + col);
                    const f32x4 g0 = {bflo(g.x), bfhi(g.x), bflo(g.y), bfhi(g.y)}, g1 = {bflo(g.z), bfhi(g.z), bflo(g.w), bfhi(g.w)};
                    float* tp = tmp + (size_t)row * DM + col;
                    *(f32x4*)tp = acc[ai][bj][m][0] * g0; *(f32x4*)(tp + 4) = acc[ai][bj][m][1] * g1;
                }
            }
    }
};
struct EpiF {
    static constexpr bool PERM = true, AFTER_DRAIN = false;
    const bf16_t* G; const float* tmp; bf16_t* MG;
    __device__ __forceinline__ void operator()(const f32x4 (&acc)[2][2][4][2], const Unit& u, int wr, int wc, int fr, int fq) const {
#pragma unroll
        for (int ai = 0; ai < 2; ++ai)
#pragma unroll
            for (int m = 0; m < 4; ++m) {
                const int row = u.pm * 256 + ai * 128 + wr * 64 + m * 16 + fr;
#pragma unroll
                for (int bj = 0; bj < 2; ++bj) {
                    const int col = u.pn * 256 + bj * 128 + wc * 32 + 8 * fq;
                    const u32x4 g = *(const u32x4*)(G + (size_t)row * 2048 + 1024 + col);
                    const f32x4 g0 = {bflo(g.x), bfhi(g.x), bflo(g.y), bfhi(g.y)}, g1 = {bflo(g.z), bfhi(g.z), bflo(g.w), bfhi(g.w)};
                    const float* tp = tmp + (size_t)row * DM + col;
                    const f32x4 t0 = *(const f32x4*)tp, t1 = *(const f32x4*)(tp + 4);
                    *(u32x4*)(MG + (size_t)row * DM + col) = pack8(t0 + acc[ai][bj][m][0] * g0, t1 + acc[ai][bj][m][1] * g1);
                }
            }
    }
};
struct EpiOut {
    static constexpr bool PERM = true, AFTER_DRAIN = false;
    const float *xp, *xs; float* h1; bf16_t* H1B; float* ssq;
    __device__ __forceinline__ void operator()(const f32x4 (&acc)[2][2][4][2], const Unit& u, int wr, int wc, int fr, int fq) const {
#pragma unroll
        for (int ai = 0; ai < 2; ++ai)
#pragma unroll
            for (int m = 0; m < 4; ++m) {
                const int row = u.pm * 256 + ai * 128 + wr * 64 + m * 16 + fr;
                const float* xr = (row < RP) ? xp + (size_t)row * DM : xs + (size_t)(row - RP) * DM;
                float sq = 0.f;
#pragma unroll
                for (int bj = 0; bj < 2; ++bj) {
                    const int col = u.pn * 256 + bj * 128 + wc * 32 + 8 * fq;
                    const f32x4 a0 = *(const f32x4*)(xr + col) + acc[ai][bj][m][0], a1 = *(const f32x4*)(xr + col + 4) + acc[ai][bj][m][1];
                    float* hp = h1 + (size_t)row * DM + col; *(f32x4*)hp = a0; *(f32x4*)(hp + 4) = a1;
                    *(u32x4*)(H1B + (size_t)row * DM + col) = pack8(a0, a1);
                    sq += (a0[0] * a0[0] + a0[1] * a0[1]) + (a0[2] * a0[2] + a0[3] * a0[3]) + (a1[0] * a1[0] + a1[1] * a1[1]) + (a1[2] * a1[2] + a1[3] * a1[3]);
                }
                sq += __shfl_xor(sq, 16); sq += __shfl_xor(sq, 32);
                if (fq == 0) ssq[(size_t)row * 16 + u.pn * 4 + wc] = sq;
            }
    }
};
struct EpiUp {
    static constexpr bool PERM = true, AFTER_DRAIN = false;
    const float* ssq; bf16_t* TT;
    __device__ __forceinline__ void operator()(const f32x4 (&acc)[2][2][4][2], const Unit& u, int wr, int wc, int fr, int fq) const {
#pragma unroll
        for (int ai = 0; ai < 2; ++ai)
#pragma unroll
            for (int m = 0; m < 4; ++m) {
                const int row = u.pm * 256 + ai * 128 + wr * 64 + m * 16 + fr;
                const float* sp = ssq + (size_t)row * 16;
                const f32x4 p0 = *(const f32x4*)sp, p1 = *(const f32x4*)(sp + 4), p2 = *(const f32x4*)(sp + 8), p3 = *(const f32x4*)(sp + 12);
                const float tot = (((p0[0] + p0[1]) + (p0[2] + p0[3])) + ((p1[0] + p1[1]) + (p1[2] + p1[3]))) + (((p2[0] + p2[1]) + (p2[2] + p2[3])) + ((p3[0] + p3[1]) + (p3[2] + p3[3])));
                const float rinv = 1.0f / sqrtf(tot * (1.0f / DM) + RMS_EPS);
#pragma unroll
                for (int bj = 0; bj < 2; ++bj) {
                    const int col = u.pn * 256 + bj * 128 + wc * 32 + 8 * fq;
                    f32x4 a0 = acc[ai][bj][m][0] * rinv, a1 = acc[ai][bj][m][1] * rinv;
#pragma unroll
                    for (int j = 0; j < 4; ++j) { a0[j] = fmaxf(a0[j], 0.f); a0[j] *= a0[j]; a1[j] = fmaxf(a1[j], 0.f); a1[j] *= a1[j]; }
                    *(u32x4*)(TT + (size_t)row * FFD + col) = pack8(a0, a1);
                }
            }
    }
};
struct EpiDown {
    static constexpr bool PERM = true, AFTER_DRAIN = false;
    float* h;
    __device__ __forceinline__ void operator()(const f32x4 (&acc)[2][2][4][2], const Unit& u, int wr, int wc, int fr, int fq) const {
#pragma unroll
        for (int ai = 0; ai < 2; ++ai)
#pragma unroll
            for (int m = 0; m < 4; ++m) {
                const int row = u.pm * 256 + ai * 128 + wr * 64 + m * 16 + fr;
#pragma unroll
                for (int bj = 0; bj < 2; ++bj) {
                    const int col = u.pn * 256 + bj * 128 + wc * 32 + 8 * fq;
                    float* hp = h + (size_t)row * DM + col;
                    const f32x4 a0 = *(const f32x4*)hp + acc[ai][bj][m][0], a1 = *(const f32x4*)(hp + 4) + acc[ai][bj][m][1];
                    *(f32x4*)hp = a0; *(f32x4*)(hp + 4) = a1;
                }
            }
    }
};

__device__ __forceinline__ void p0_transpose_item(const float* W, int K, int N, bf16* WT, const float* gk, LAS float* scr, int item, int lane) {
    const int nblk = N / 32, kb = item / nblk, nb = item % nblk, k0 = 64 * kb, n0 = 32 * nb;
#pragma unroll 8
    for (int i = 0; i < 32; ++i) { const int kk = 2 * i + (lane >> 5); float w = W[(size_t)(k0 + kk) * N + n0 + (lane & 31)]; if (gk) w *= gk[k0 + kk]; scr[kk * 33 + (lane & 31)] = w; }
    LDS_WAIT(); asm volatile("" ::: "memory");
    const int c = lane & 7;
#pragma unroll
    for (int j = 0; j < 4; ++j) { const int n = (lane >> 3) + 8 * j; const LAS float* s = scr + (8 * c) * 33 + n;
        v4u o; o.x = pk2(s[0 * 33], s[1 * 33]); o.y = pk2(s[2 * 33], s[3 * 33]); o.z = pk2(s[4 * 33], s[5 * 33]); o.w = pk2(s[6 * 33], s[7 * 33]);
        *(GAS v4u*)(WT + (size_t)(n0 + n) * K + k0 + 8 * c) = o; }
    LDS_WAIT(); asm volatile("" ::: "memory");
}
__device__ __forceinline__ float rope_invfreq(int i) { return powf(500000.0f, -(float)i / 8.0f); }

struct Ptrs {
    const float *xp, *xs, *meta, *gmix, *win, *bgate, *sink, *wao, *wf, *wout, *gmlp, *wup, *wdn, *gfin; float* out;
    bf16 *WinT, *WaoT, *WfT, *WoutT, *WupT, *WdnT, *Gt, *Q, *K, *V, *U, *A, *MG, *TT, *XN, *AB, *H1B, *Km, *Vm, *Y;
    float *ssq1, *rope; float2 *tabLP, *tabLS, *tabN1P, *tabN1S;
};

__device__ __forceinline__ void p0_prologue(const Ptrs& P, LAS unsigned char* lds, int vcu, int G, int tid, int lane, int wave) {
    LAS float* scr = (LAS float*)(lds + wave * 16384);
    LAS float* t128 = (LAS float*)(lds + TAB128_OFF);
    if (tid < 128) { t128[tid] = cospif((float)tid / 64.0f); t128[128 + tid] = sinpif((float)tid / 64.0f); }
    __syncthreads();
    const int gw = vcu * NWAVES + wave, NGW = G * NWAVES;
    constexpr int I_IN = (DM / 64) * (INW / 32), I_AO = (512 / 64) * (DM / 32), I_OUT = (DM / 64) * (DM / 32), I_UP = (DM / 64) * (FFD / 32), I_DN = (FFD / 64) * (DM / 32);
    constexpr int NT_ITEMS = I_IN + I_AO + I_OUT + I_UP + I_DN;
    for (int it = gw; it < NT_ITEMS; it += NGW) {
        int r = it;
        if (r < I_IN) { p0_transpose_item(P.win, DM, INW, P.WinT, nullptr, scr, r, lane); continue; } r -= I_IN;
        if (r < I_AO) { p0_transpose_item(P.wao, 512, DM, P.WaoT, nullptr, scr, r, lane); continue; } r -= I_AO;
        if (r < I_OUT) { p0_transpose_item(P.wout, DM, DM, P.WoutT, nullptr, scr, r, lane); continue; } r -= I_OUT;
        if (r < I_UP) { p0_transpose_item(P.wup, DM, FFD, P.WupT, P.gmlp, scr, r, lane); continue; } r -= I_UP;
        p0_transpose_item(P.wdn, FFD, DM, P.WdnT, nullptr, scr, r, lane);
    }
    for (int it = gw; it < 16 * 1024; it += NGW) {
        const int nb = it & 15, kk = it >> 4, part = kk >> 9, g = (kk >> 7) & 3, c = kk & 127, n = nb * 64 + lane;
        const float* wp = P.wf + (size_t)(g * 128) * DM + n; const LAS float* tb = t128 + part * 128;
        float a = 0.f;
#pragma unroll 16
        for (int m = 0; m < 128; ++m) a += tb[(c * m) & 127] * wp[(size_t)m * DM];
        a *= 0.08838834764831845f; if (part) a = -a;
        P.WfT[(size_t)n * DM + kk] = (bf16)f2bf(a);
    }
    for (int r = gw; r < R; r += NGW) {
        const float* xr = (r < RP) ? P.xp + (size_t)r * DM : P.xs + (size_t)(r - RP) * DM;
        const GAS f32x4* x4 = (const GAS f32x4*)xr + lane; const GAS f32x4* g4 = (const GAS f32x4*)P.gmix + lane;
        f32x4 v[4]; float s = 0.f;
#pragma unroll
        for (int j = 0; j < 4; ++j) { v[j] = x4[64 * j]; s += (v[j].x * v[j].x + v[j].y * v[j].y) + (v[j].z * v[j].z + v[j].w * v[j].w); }
        const float rinv = 1.0f / sqrtf(wave_sum(s) * (1.0f / DM) + RMS_EPS);
        GAS unsigned long long* o8 = (GAS unsigned long long*)(P.XN + (size_t)r * DM) + lane;
#pragma unroll
        for (int j = 0; j < 4; ++j) { const f32x4 gg = g4[64 * j]; const f32x4 y = v[j] * rinv * gg;
            o8[64 * j] = (unsigned long long)pk2(y.x, y.y) | ((unsigned long long)pk2(y.z, y.w) << 32); }
    }
    for (int it = gw; it < 16 * 12; it += NGW) {
        const int m = it / 12, cb = it % 12;
        { const float* mr = P.meta + (size_t)m * DM; float s = 0.f; float xv[16];
#pragma unroll
          for (int j = 0; j < 16; ++j) { xv[j] = mr[lane + 64 * j]; s += xv[j] * xv[j]; }
          const float rinv = 1.0f / sqrtf(wave_sum(s) * (1.0f / DM) + RMS_EPS);
#pragma unroll
          for (int j = 0; j < 16; ++j) scr[lane + 64 * j] = xv[j] * rinv * P.gmix[lane + 64 * j];
          LDS_WAIT(); asm volatile("" ::: "memory"); }
        const int col = 512 + cb * 64 + lane; const float* wp = P.win + col;
        float a = 0.f;
#pragma unroll 32
        for (int k = 0; k < DM; ++k) a += scr[k] * wp[(size_t)k * INW];
        LDS_WAIT(); asm volatile("" ::: "memory");
        if (cb < 2) {
            const float o = __shfl_xor(a, 8);
            if (lane < 16) { const float ang = (float)m * rope_invfreq(lane & 7); const float cs = cosf(ang), sn = sinf(ang); a = (lane < 8) ? a * cs - o * sn : a * cs + o * sn; }
            P.Km[m * 128 + cb * 64 + lane] = (bf16)f2bf(a);
        } else if (cb < 4) {
            P.Vm[m * 128 + (cb - 2) * 64 + lane] = (bf16)f2bf(a);
        } else {
            const bf16 ub = (bf16)f2bf(a);
            for (int sq = 0; sq < NBP + NBS; ++sq) P.U[(size_t)(useq_base(sq) + m) * 512 + (cb - 4) * 64 + lane] = ub;
        }
    }
    const int gt = (vcu * NWAVES + wave) * 64 + lane, NGT = G * NWAVES * 64;
    for (int e = gt; e < LS * 8; e += NGT) { const int pos = e >> 3, i = e & 7; const float ang = (float)pos * rope_invfreq(i); P.rope[pos * 16 + i] = cosf(ang); P.rope[pos * 16 + 8 + i] = sinf(ang); }
    for (int e = gt; e < LP; e += NGT) { const float t = 2.0f * (float)e / (float)LP; P.tabLP[e] = make_float2(cospif(t), sinpif(t)); }
    for (int e = gt; e < LS; e += NGT) { const float t = 2.0f * (float)e / (float)LS; P.tabLS[e] = make_float2(cospif(t), sinpif(t)); }
    for (int e = gt; e < N1P; e += NGT) { const float t = 2.0f * (float)e / (float)N1P; P.tabN1P[e] = make_float2(cospif(t), sinpif(t)); }
    for (int e = gt; e < N1S; e += NGT) { const float t = 2.0f * (float)e / (float)N1S; P.tabN1S[e] = make_float2(cospif(t), sinpif(t)); }
}

__device__ __forceinline__ void attn_key(const bf16* kr, const bf16* vr, bool valid, const float (&q)[64], float (&o)[64], float& m, float& l) {
    float s = 0.f;
#pragma unroll
    for (int c = 0; c < 8; ++c) { const v4u kk = *(const v4u*)(kr + 8 * c);
        s += q[8 * c + 0] * bflo(kk.x) + q[8 * c + 1] * bfhi(kk.x) + q[8 * c + 2] * bflo(kk.y) + q[8 * c + 3] * bfhi(kk.y)
           + q[8 * c + 4] * bflo(kk.z) + q[8 * c + 5] * bfhi(kk.z) + q[8 * c + 6] * bflo(kk.w) + q[8 * c + 7] * bfhi(kk.w); }
    if (!valid) s = -INFINITY;
    const float mn = fmaxf(m, s), a = __builtin_amdgcn_exp2f(m - mn), p = __builtin_amdgcn_exp2f(s - mn);
    l = l * a + p; m = mn;
#pragma unroll
    for (int c = 0; c < 8; ++c) { const v4u vv = *(const v4u*)(vr + 8 * c);
        o[8 * c + 0] = o[8 * c + 0] * a + p * bflo(vv.x); o[8 * c + 1] = o[8 * c + 1] * a + p * bfhi(vv.x);
        o[8 * c + 2] = o[8 * c + 2] * a + p * bflo(vv.y); o[8 * c + 3] = o[8 * c + 3] * a + p * bfhi(vv.y);
        o[8 * c + 4] = o[8 * c + 4] * a + p * bflo(vv.z); o[8 * c + 5] = o[8 * c + 5] * a + p * bfhi(vv.z);
        o[8 * c + 6] = o[8 * c + 6] * a + p * bflo(vv.w); o[8 * c + 7] = o[8 * c + 7] * a + p * bfhi(vv.w); }
}
__device__ __forceinline__ void attn_scalar(const Ptrs& P, int gw, int NGW, int lane) {
    for (int it = gw; it < 8 * (R / 64); it += NGW) {
        const int h = it & 7, tb = it >> 3, hk = h >> 2, r = tb * 64 + lane;
        int seq, s, S; row_decode(r, seq, s, S); const int rb = rseq_base(seq);
        float q[64], o[64];
#pragma unroll
        for (int c = 0; c < 8; ++c) { const v4u qq = *(const v4u*)(P.Q + (size_t)r * 512 + h * 64 + 8 * c);
            q[8 * c + 0] = bflo(qq.x); q[8 * c + 1] = bfhi(qq.x); q[8 * c + 2] = bflo(qq.y); q[8 * c + 3] = bfhi(qq.y);
            q[8 * c + 4] = bflo(qq.z); q[8 * c + 5] = bfhi(qq.z); q[8 * c + 6] = bflo(qq.w); q[8 * c + 7] = bfhi(qq.w); }
#pragma unroll
        for (int d = 0; d < 64; ++d) o[d] = 0.f;
        float m = P.sink[h] * LOG2E, l = 1.0f;
        for (int j = 0; j < NMETA; ++j) attn_key(P.Km + j * 128 + hk * 64, P.Vm + j * 128 + hk * 64, true, q, o, m, l);
        for (int dj = -WINDOW; dj <= WINDOW; ++dj) {
            const int sp = s + dj; const bool valid = (sp >= 0) && (sp < S); const int spc = sp < 0 ? 0 : (sp >= S ? S - 1 : sp);
            attn_key(P.K + (size_t)(rb + spc) * 128 + hk * 64, P.V + (size_t)(rb + spc) * 128 + hk * 64, valid, q, o, m, l);
        }
        const float il = 1.0f / l;
#pragma unroll
        for (int c = 0; c < 8; ++c) { v4u w; w.x = pk2(o[8 * c + 0] * il, o[8 * c + 1] * il); w.y = pk2(o[8 * c + 2] * il, o[8 * c + 3] * il); w.z = pk2(o[8 * c + 4] * il, o[8 * c + 5] * il); w.w = pk2(o[8 * c + 6] * il, o[8 * c + 7] * il);
            *(v4u*)(P.A + (size_t)r * 512 + h * 64 + 8 * c) = w; }
    }
}

template <int N1, int N2>
__device__ __forceinline__ void fft1_scalar(const bf16* U, bf16* Y, const float2* tab, int seq0, int nseq, int wg, int G, int tid) {
    for (int it = wg; it < nseq * N2; it += G) {
        const int seq = seq0 + it / N2, l2 = it % N2, col = tid;
        const bf16* ub = U + (size_t)useq_base(seq) * 512; bf16* yb = Y + (size_t)useq_base(seq) * 1024;
        float u[N1];
#pragma unroll
        for (int l1 = 0; l1 < N1; ++l1) u[l1] = bf2f(ub[(size_t)(l1 * N2 + l2) * 512 + col]);
        for (int k1 = 0; k1 < N1; ++k1) {
            float ar = 0.f, ai = 0.f; int idx = 0;
#pragma unroll
            for (int l1 = 0; l1 < N1; ++l1) { const float2 t = tab[idx]; ar += u[l1] * t.x; ai -= u[l1] * t.y; idx += k1; if (idx >= N1) idx -= N1; }
            yb[(size_t)((0 * N1 + k1) * N2 + l2) * 512 + col] = (bf16)f2bf(ar);
            yb[(size_t)((1 * N1 + k1) * N2 + l2) * 512 + col] = (bf16)f2bf(ai);
        }
    }
}
template <int N1, int N2>
__device__ __forceinline__ void fft2_scalar(const bf16* Y, bf16* AB, const float2* tab, int L, int seq0, int nseq, LAS unsigned char* lds, int wg, int G, int tid) {
    const float isl = 1.0f / sqrtf((float)L);
    for (int it = wg; it < nseq * N1 * 2; it += G) {
        const int half = it & 1, k1 = (it >> 1) % N1, seq = seq0 + (it >> 1) / N1;
        const bf16* yb = Y + (size_t)useq_base(seq) * 1024;
        for (int idx = tid; idx < 2 * N2 * 32; idx += NWAVES * 64) { const int row = idx >> 5, ch = idx & 31, ri = row / N2, l2 = row % N2;
            *(LAS v4u*)(lds + row * 512 + ch * 16) = *(const v4u*)(yb + (size_t)((ri * N1 + k1) * N2 + l2) * 512 + half * 256 + ch * 8); }
        __syncthreads();
        const int col = tid & 255, kh = __builtin_amdgcn_readfirstlane(tid >> 8);
        const LAS bf16* sl = (const LAS bf16*)lds;
        for (int k2 = kh * (N2 / 2); k2 < (kh + 1) * (N2 / 2); ++k2) {
            const int k = k1 + N1 * k2; float a = 0.f, b = 0.f; int ix = 0;
            for (int l2 = 0; l2 < N2; ++l2) { const float yr = bf2f(sl[l2 * 256 + col]), yi = bf2f(sl[(N2 + l2) * 256 + col]); const float2 t = tab[ix];
                a += yr * t.x + yi * t.y; b += yr * t.y - yi * t.x; ix += k; if (ix >= L) ix -= L; }
            if (k >= NMETA) { const size_t r = (size_t)(rseq_base(seq) + k - NMETA);
                AB[r * 1024 + half * 256 + col] = (bf16)f2bf(a * isl); AB[r * 1024 + 512 + half * 256 + col] = (bf16)f2bf(b * isl); }
        }
        __syncthreads();
    }
}

struct Args { const float* in[14]; float* out; unsigned char* ws; int ph_lo, ph_hi; };
__global__ void __launch_bounds__(NWAVES * 64, 2) mk_fwd(Args args) {
    extern __shared__ __attribute__((aligned(16))) unsigned char lds_raw[];
    LAS unsigned char* lds = (LAS unsigned char*)lds_raw;
    volatile LAS unsigned* MISC = (volatile LAS unsigned*)(lds + MISC_OFF);
    const int tid = threadIdx.x, lane = tid & 63, wave = __builtin_amdgcn_readfirstlane(tid >> 6);
    const int G = gridDim.x, bx = blockIdx.x, vcu = (G % 8 == 0) ? (bx % 8) * (G / 8) + bx / 8 : bx;
    unsigned char* ws = args.ws;
    gu32* ctl = (gu32*)(ws + WS_CTL);
    Ptrs P;
    P.xp = args.in[0]; P.xs = args.in[1]; P.meta = args.in[2]; P.gmix = args.in[3]; P.win = args.in[4]; P.bgate = args.in[5]; P.sink = args.in[6]; P.wao = args.in[7];
    P.wf = args.in[8]; P.wout = args.in[9]; P.gmlp = args.in[10]; P.wup = args.in[11]; P.wdn = args.in[12]; P.gfin = args.in[13]; P.out = args.out;
    P.WinT = (bf16*)(ws + WS_WIN); P.WaoT = (bf16*)(ws + WS_WAO); P.WfT = (bf16*)(ws + WS_WF); P.WoutT = (bf16*)(ws + WS_WOUT); P.WupT = (bf16*)(ws + WS_WUP); P.WdnT = (bf16*)(ws + WS_WDN);
    P.Gt = (bf16*)(ws + WS_G); P.Q = (bf16*)(ws + WS_Q); P.K = (bf16*)(ws + WS_K); P.V = (bf16*)(ws + WS_V); P.U = (bf16*)(ws + WS_U); P.A = (bf16*)(ws + WS_A);
    P.MG = (bf16*)(ws + WS_MERGED); P.TT = (bf16*)(ws + WS_TT); P.XN = (bf16*)(ws + WS_H); P.AB = (bf16*)(ws + WS_H); P.H1B = (bf16*)(ws + WS_H);
    P.Km = (bf16*)(ws + WS_KMETA); P.Vm = (bf16*)(ws + WS_VMETA); P.Y = (bf16*)args.out;
    P.ssq1 = (float*)(ws + WS_SSQ1); P.rope = (float*)(ws + WS_ROPE);
    P.tabLP = (float2*)(ws + WS_TABLP); P.tabLS = (float2*)(ws + WS_TABLS); P.tabN1P = (float2*)(ws + WS_TABN1P); P.tabN1S = (float2*)(ws + WS_TABN1S);

    for (int u = tid; u < (LDS_BYTES - LDSCTL_OFF) / 4; u += NWAVES * 64) ((LAS unsigned*)(lds + LDSCTL_OFF))[u] = 0u;
    __syncthreads();
    XcdBarrier bar; bar.bar = (unsigned*)(ctl + CW_BAR); bar.x = 0; bar.st = nullptr;
    if (MK_N_LAUNCHES == 1) bar = xcd_barrier_post((unsigned*)(ctl + CW_BAR), MISC + 8);
    const int lo = args.ph_lo, hi = args.ph_hi;
#define IN(k) (lo <= (k) && (k) < hi)
#define SEAM(k) do { if (IN(k) && IN((k) + 1)) xcd_barrier(bar); } while (0)
    const int gw = vcu * NWAVES + wave, NGW = G * NWAVES;

    if (IN(0)) { p0_prologue(P, lds, vcu, G, tid, lane, wave); SEAM(0); }
    if (IN(1)) {
        pg8::Gemm g{P.XN, P.WinT, R, INW, DM}; pg8::StaticOrder S; S.init(R, INW, G, bx);
        EpiIn E{P.Q, P.K, P.V, P.U, P.Gt, P.bgate, P.rope};
        pg8::gemm_phase<EpiIn, pg8::StaticOrder, true, true>(lds, g, S, E);
        SEAM(1);
    }
    if (IN(2)) {
        attn_scalar(P, gw, NGW, lane);
        fft1_scalar<N1P, N2P>(P.U, P.Y, P.tabN1P, 0, NBP, vcu, G, tid);
        fft1_scalar<N1S, N2S>(P.U, P.Y, P.tabN1S, NBP, NBS, vcu, G, tid);
        SEAM(2);
    }
    if (IN(3)) {
        fft2_scalar<N1P, N2P>(P.Y, P.AB, P.tabLP, LP, 0, NBP, lds, vcu, G, tid);
        fft2_scalar<N1S, N2S>(P.Y, P.AB, P.tabLS, LS, NBP, NBS, lds, vcu, G, tid);
        SEAM(3);
    }
    if (IN(4)) {
        pg8::Gemm g{P.A, P.WaoT, R, DM, 512}; pg8::StaticOrder S; S.init(R, DM, G, bx);
        EpiAO E{P.Gt, P.out};
        pg8::gemm_phase<EpiAO, pg8::StaticOrder, true, true>(lds, g, S, E);
        SEAM(4);
    }
    if (IN(5)) {
        pg8::Gemm g{P.AB, P.WfT, R, DM, DM}; pg8::StaticOrder S; S.init(R, DM, G, bx);
        EpiF E{P.Gt, P.out, P.MG};
        pg8::gemm_phase<EpiF, pg8::StaticOrder, true, true>(lds, g, S, E);
        SEAM(5);
    }
    if (IN(6)) {
        pg8::Gemm g{P.MG, P.WoutT, R, DM, DM}; pg8::StaticOrder S; S.init(R, DM, G, bx);
        EpiOut E{P.xp, P.xs, P.out, P.H1B, P.ssq1};
        pg8::gemm_phase<EpiOut, pg8::StaticOrder, true, true>(lds, g, S, E);
        SEAM(6);
    }
    if (IN(7)) {
        pg8::Gemm g{P.H1B, P.WupT, R, FFD, DM}; pg8::StaticOrder S; S.init(R, FFD, G, bx);
        EpiUp E{P.ssq1, P.TT};
        pg8::gemm_phase<EpiUp, pg8::StaticOrder, true, true>(lds, g, S, E);
        SEAM(7);
    }
    if (IN(8)) {
        pg8::Gemm g{P.TT, P.WdnT, R, DM, FFD}; pg8::StaticOrder S; S.init(R, DM, G, bx);
        EpiDown E{P.out};
        pg8::gemm_phase<EpiDown, pg8::StaticOrder, true, true>(lds, g, S, E);
        SEAM(8);
    }
    if (IN(9)) {
        for (int r = gw; r < R; r += NGW) {
            GAS f32x4* h4 = (GAS f32x4*)(P.out + (size_t)r * DM) + lane; const GAS f32x4* g4 = (const GAS f32x4*)P.gfin + lane;
            f32x4 v[4]; float s = 0.f;
#pragma unroll
            for (int j = 0; j < 4; ++j) { v[j] = h4[64 * j]; s += (v[j].x * v[j].x + v[j].y * v[j].y) + (v[j].z * v[j].z + v[j].w * v[j].w); }
            const float rinv = 1.0f / sqrtf(wave_sum(s) * (1.0f / DM) + RMS_EPS);
#pragma unroll
            for (int j = 0; j < 4; ++j) h4[64 * j] = v[j] * rinv * g4[64 * j];
        }
    }
#undef IN
#undef SEAM
}

extern "C" void kernel_launch(void* const* d_in, const int* in_sizes, int n_in, void* d_out, int out_size, void* d_ws, size_t ws_size, hipStream_t stream) {
    static int grid = 0;
    if (grid == 0) {
        if (n_in != 14 || in_sizes[0] != RP * DM || in_sizes[1] != RS * DM || out_size != R * DM || ws_size < WS_END) {
            fprintf(stderr, "kernel_launch: unexpected shapes: n_in %d in0 %d in1 %d out %d ws %zu (need >= %zu); nothing launched\n", n_in, n_in > 0 ? in_sizes[0] : -1, n_in > 1 ? in_sizes[1] : -1, out_size, ws_size, (size_t)WS_END);
            grid = -1; return; }
        int dev = 0, cus = 0;
        if (hipGetDevice(&dev) != hipSuccess || hipDeviceGetAttribute(&cus, hipDeviceAttributeMultiprocessorCount, dev) != hipSuccess) { grid = -1; return; }
        if (hipFuncSetAttribute((const void*)mk_fwd, hipFuncAttributeMaxDynamicSharedMemorySize, LDS_BYTES) != hipSuccess) { fprintf(stderr, "kernel_launch: hipFuncSetAttribute failed\n"); grid = -1; return; }
        int per_cu = 0;
        if (hipOccupancyMaxActiveBlocksPerMultiprocessor(&per_cu, (const void*)mk_fwd, NWAVES * 64, LDS_BYTES) != hipSuccess || per_cu < 1)
            fprintf(stderr, "kernel_launch: note: occupancy query reports %d workgroups per CU\n", per_cu);
        (void)hipGetLastError();
        grid = cus;
    }
    if (grid < 0) return;
    if (hipMemsetAsync((char*)d_ws + WS_CTL, 0, CTL_ZERO_BYTES, stream) != hipSuccess) { fprintf(stderr, "kernel_launch: memset failed\n"); return; }
    Args a{};
    for (int i = 0; i < 14; ++i) a.in[i] = (const float*)d_in[i];
    a.out = (float*)d_out; a.ws = (unsigned char*)d_ws;
    if (MK_N_LAUNCHES == 1) { a.ph_lo = 0; a.ph_hi = N_PHASES; hipLaunchKernelGGL(mk_fwd, dim3(grid), dim3(NWAVES * 64), LDS_BYTES, stream, a); }
    else for (int p = 0; p < N_PHASES; ++p) { a.ph_lo = p; a.ph_hi = p + 1; hipLaunchKernelGGL(mk_fwd, dim3(grid), dim3(NWAVES * 64), LDS_BYTES, stream, a); }
    const hipError_t le = hipPeekAtLastError();
    if (le != hipSuccess) fprintf(stderr, "kernel_launch: launch failed: %s\n", hipGetErrorName(le));
}
```

```cpp
#include <hip/hip_runtime.h>
#include <cstdio>
#include <cstdint>
#include <cmath>
namespace pg8 {
#define PG8_LAS __attribute__((address_space(3)))
typedef unsigned short bf16_t;
typedef short bf16x8 __attribute__((ext_vector_type(8)));
typedef float f32x4 __attribute__((ext_vector_type(4)));
typedef unsigned u32x4 __attribute__((ext_vector_type(4)));
constexpr int BM = 256, BK = 64, HALF = 128, HTB = HALF * BK * 2  , STAGE_BYTES = 8 * HTB, NXCD = 8, WGM = 8;

__host__ __device__ __forceinline__ int lds_byte(int r, int c) { const int st = (r >> 4) * 2 + (c >> 5), rr = r & 15, cc = c & 31, ob = rr * 64 + cc * 2; return st * 1024 + (ob ^ (((ob >> 9) & 1) << 5)); }
__host__ __device__ __forceinline__ void stage_rc(int b, int& R, int& C) { const int st = b / 1024, sb = b % 1024, swz = sb ^ (((sb >> 9) & 1) << 5); R = (st >> 1) * 16 + swz / 64; C = (st & 1) * 32 + (swz % 64) / 2; }
__host__ __device__ __forceinline__ int perm32(int rho) { const int n = rho >> 4, i = rho & 15; return 8 * (i >> 2) + 4 * n + (i & 3); }

struct Unit { int pm, pn; };
struct Gemm { const bf16_t* A; const bf16_t* Bt; int M, N, K; };

struct StaticOrder {
    int nM, nN, nwg, G, c;
    __host__ __device__ void init(int M, int N, int G_, int c_) { nM = M / BM; nN = N / BM; nwg = nM * nN; G = G_; c = c_; }
    __host__ __device__ bool next(int i, Unit& u) const {
        const long L = (long)i * G + c; if (L >= nwg) return false;
        int wgid = (int)L; { const int q = nwg / NXCD, r = nwg % NXCD, xcd = wgid % NXCD, off = wgid / NXCD; wgid = (xcd < r ? xcd * (q + 1) : r * (q + 1) + (xcd - r) * q) + off; }
        const int nig = WGM * nN, gid = wgid / nig, fm = gid * WGM, gsz = (nM - fm) < WGM ? (nM - fm) : WGM;
        u.pm = fm + ((wgid % nig) % gsz); u.pn = (wgid % nig) / gsz; return true;
    }
    __device__ __forceinline__ void a_ready(const Unit&) const {}
    __device__ __forceinline__ void done(const Unit&) const {}
};

__device__ __forceinline__ unsigned cvt_pk_bf16(float lo, float hi) { unsigned r; asm volatile("v_cvt_pk_bf16_f32 %0, %1, %2" : "=v"(r) : "v"(lo), "v"(hi)); return r; }
typedef float f32x2 __attribute__((ext_vector_type(2)));
template <class Epi, class Sched, bool ALIGN_EPI = false, bool SP2 = false>
__device__ __forceinline__ void gemm_phase(PG8_LAS unsigned char* lds, const Gemm g, const Sched& S, const Epi& E) {
    const int tid = threadIdx.x, wid = __builtin_amdgcn_readfirstlane(tid >> 6), lane = tid & 63, wr = wid >> 2, wc = wid & 3, fr = lane & 15, fq = lane >> 4;
    const int K = g.K, nt = K / BK;
    unsigned voffA[2], voffB[2];
#pragma unroll
    for (int i = 0; i < 2; ++i) { int R, C; stage_rc(tid * 16 + i * 8192, R, C); const int Rb = Epi::PERM ? ((R & ~31) + perm32(R & 31)) : R;
        voffA[i] = (unsigned)(R * K + C) * 2u; voffB[i] = (unsigned)(Rb * K + C) * 2u; }
    const size_t kstep = (size_t)(BK * 2);
    const size_t hstep = (size_t)HALF * K * 2;
    const size_t tstep = 2 * hstep;
    const unsigned ldsw = (unsigned)wid * 1024u;
    const int aoff = lds_byte(wr * 64 + fr, fq * 8), boff = lds_byte(wc * 32 + fr, fq * 8);
#define PG8_SA(b, h) (((b) * 2 + (h)) * HTB)
#define PG8_SB(b, h) ((4 + (b) * 2 + (h)) * HTB)
#define PG8_STAGE(bufoff, gbase, voff) do { _Pragma("unroll") for (int _i = 0; _i < 2; ++_i) \
        __builtin_amdgcn_global_load_lds((const unsigned*)((const char*)(gbase) + (voff)[_i]), (PG8_LAS unsigned*)(lds + (bufoff) + ldsw + _i * 8192), 16, 0, 0); } while (0)
#define PG8_LDA(dst, b, h) do { _Pragma("unroll") for (int m = 0; m < 4; ++m) _Pragma("unroll") for (int k = 0; k < 2; ++k) dst[m][k] = *(const PG8_LAS bf16x8*)(lds + PG8_SA(b, h) + aoff + m * 2048 + k * 1024); } while (0)
#define PG8_LDB(dst, b, h) do { _Pragma("unroll") for (int n = 0; n < 2; ++n) _Pragma("unroll") for (int k = 0; k < 2; ++k) dst[n][k] = *(const PG8_LAS bf16x8*)(lds + PG8_SB(b, h) + boff + n * 2048 + k * 1024); } while (0)
#define PG8_MMA(ai, bj, At, Bt) do { __builtin_amdgcn_s_setprio(1); _Pragma("unroll") for (int m = 0; m < 4; ++m) _Pragma("unroll") for (int n = 0; n < 2; ++n) _Pragma("unroll") for (int k = 0; k < 2; ++k) \
        acc[ai][bj][m][n] = __builtin_amdgcn_mfma_f32_16x16x32_bf16(Bt[n][k], At[m][k], acc[ai][bj][m][n], 0, 0, 0); __builtin_amdgcn_s_setprio(0); } while (0)
#define PG8_WAIT_V(n) asm volatile("s_waitcnt vmcnt(" #n ")" ::: "memory")
#define PG8_WAIT_L(n) asm volatile("s_waitcnt lgkmcnt(" #n ")" ::: "memory")
#define PG8_BAR __builtin_amdgcn_s_barrier()
#define PG8_SCHED __builtin_amdgcn_sched_barrier(0)
    Unit cur, nxt; int ui = 0;
    if (!S.next(0, cur)) return;
    f32x4 acc[2][2][4][2];
#pragma unroll
    for (int a = 0; a < 2; ++a)
#pragma unroll
        for (int b = 0; b < 2; ++b)
#pragma unroll
            for (int m = 0; m < 4; ++m)
#pragma unroll
                for (int n = 0; n < 2; ++n) acc[a][b][m][n] = (f32x4){0.f, 0.f, 0.f, 0.f};
    bf16x8 At[4][2], B0[2][2], B1[2][2];
    const char* cA = (const char*)g.A + (size_t)cur.pm * tstep; const char* cB = (const char*)g.Bt + (size_t)cur.pn * tstep;
    S.a_ready(cur);
    if constexpr (SP2) {
        PG8_STAGE(PG8_SB(0, 0), cB, voffB); PG8_STAGE(PG8_SB(0, 1), cB + hstep, voffB); PG8_STAGE(PG8_SA(0, 0), cA, voffA); PG8_STAGE(PG8_SA(0, 1), cA + hstep, voffA);
        if (wr == 1) PG8_BAR;
        PG8_WAIT_V(2); PG8_BAR;
        PG8_STAGE(PG8_SB(1, 0), cB + kstep, voffB); PG8_STAGE(PG8_SA(1, 0), cA + kstep, voffA); PG8_STAGE(PG8_SB(1, 1), cB + hstep + kstep, voffB);
        PG8_WAIT_V(6); PG8_BAR;
    } else {
        PG8_STAGE(PG8_SB(0, 0), cB, voffB); PG8_STAGE(PG8_SA(0, 0), cA, voffA); PG8_STAGE(PG8_SB(0, 1), cB + hstep, voffB); PG8_STAGE(PG8_SA(0, 1), cA + hstep, voffA);
        if (wr == 1) PG8_BAR;
        PG8_WAIT_V(4); PG8_BAR;
        PG8_STAGE(PG8_SB(1, 0), cB + kstep, voffB); PG8_STAGE(PG8_SA(1, 0), cA + kstep, voffA); PG8_STAGE(PG8_SB(1, 1), cB + hstep + kstep, voffB);
        PG8_WAIT_V(6); PG8_BAR;
    }
    for (;;) {
        const bool has_next = S.next(ui + 1, nxt);
        const char* nA = has_next ? (const char*)g.A + (size_t)nxt.pm * tstep : cA; const char* nB = has_next ? (const char*)g.Bt + (size_t)nxt.pn * tstep : cB;
        for (int t = 0; t < nt; t += 2) {
            const bool last = (t == nt - 2);
            const char* a1 = cA + (size_t)(t + 1) * kstep;
            const char* a2 = last ? nA : cA + (size_t)(t + 2) * kstep; const char* b2 = last ? nB : cB + (size_t)(t + 2) * kstep;
            const char* a3 = a2 + kstep; const char* b3 = b2 + kstep;
            if (last && has_next) S.a_ready(nxt);
            if constexpr (SP2) {
            PG8_LDB(B0, 0, 0); PG8_LDB(B1, 0, 1); PG8_SCHED; PG8_LDA(At, 0, 0); PG8_STAGE(PG8_SA(1, 1), a1 + hstep, voffA);
            PG8_WAIT_V(8); PG8_WAIT_L(0); PG8_BAR; PG8_MMA(0, 0, At, B0); PG8_MMA(0, 1, At, B1); PG8_BAR; PG8_SCHED;
            PG8_LDA(At, 0, 1); PG8_STAGE(PG8_SB(0, 0), b2, voffB); PG8_STAGE(PG8_SB(0, 1), b2 + hstep, voffB); PG8_STAGE(PG8_SA(0, 0), a2, voffA);
            PG8_WAIT_V(8); PG8_WAIT_L(0); PG8_BAR; PG8_MMA(1, 0, At, B0); PG8_MMA(1, 1, At, B1); PG8_BAR; PG8_SCHED;
            PG8_LDB(B0, 1, 0); PG8_LDB(B1, 1, 1); PG8_SCHED; PG8_LDA(At, 1, 0); PG8_STAGE(PG8_SA(0, 1), a2 + hstep, voffA);
            PG8_WAIT_V(8); PG8_WAIT_L(0); PG8_BAR; PG8_MMA(0, 0, At, B0); PG8_MMA(0, 1, At, B1); PG8_BAR; PG8_SCHED;
            PG8_LDA(At, 1, 1); PG8_STAGE(PG8_SB(1, 0), b3, voffB); PG8_STAGE(PG8_SB(1, 1), b3 + hstep, voffB); PG8_STAGE(PG8_SA(1, 0), a3, voffA);
            PG8_WAIT_V(8); PG8_WAIT_L(0); PG8_BAR; PG8_MMA(1, 0, At, B0); PG8_MMA(1, 1, At, B1); PG8_BAR; PG8_SCHED;
            } else {
            PG8_LDB(B0, 0, 0); PG8_SCHED; PG8_LDA(At, 0, 0); PG8_STAGE(PG8_SA(1, 1), a1 + hstep, voffA);
            PG8_WAIT_L(8); PG8_BAR; PG8_WAIT_L(0); PG8_MMA(0, 0, At, B0); PG8_BAR; PG8_SCHED;
            PG8_LDB(B1, 0, 1); PG8_STAGE(PG8_SB(0, 0), b2, voffB);
            PG8_BAR; PG8_WAIT_L(0); PG8_MMA(0, 1, At, B1); PG8_BAR;
            PG8_LDA(At, 0, 1); PG8_STAGE(PG8_SA(0, 0), a2, voffA);
            PG8_BAR; PG8_WAIT_L(0); PG8_MMA(1, 0, At, B0); PG8_BAR; PG8_SCHED;
            PG8_STAGE(PG8_SB(0, 1), b2 + hstep, voffB);
            PG8_WAIT_V(6); PG8_BAR; PG8_MMA(1, 1, At, B1); PG8_BAR;
            PG8_LDB(B0, 1, 0); PG8_SCHED; PG8_LDA(At, 1, 0); PG8_STAGE(PG8_SA(0, 1), a2 + hstep, voffA);
            PG8_WAIT_L(8); PG8_BAR; PG8_WAIT_L(0); PG8_MMA(0, 0, At, B0); PG8_BAR; PG8_SCHED;
            PG8_LDB(B1, 1, 1); PG8_STAGE(PG8_SB(1, 0), b3, voffB);
            PG8_BAR; PG8_WAIT_L(0); PG8_MMA(0, 1, At, B1); PG8_BAR;
            PG8_LDA(At, 1, 1); PG8_STAGE(PG8_SA(1, 0), a3, voffA);
            PG8_BAR; PG8_WAIT_L(0); PG8_MMA(1, 0, At, B0); PG8_BAR; PG8_SCHED;
            PG8_STAGE(PG8_SB(1, 1), b3 + hstep, voffB);
            PG8_WAIT_V(6); PG8_BAR; PG8_MMA(1, 1, At, B1); PG8_BAR;
            }
        }
        if constexpr (ALIGN_EPI) { if (wr == 0) PG8_BAR; }
        if constexpr (!Epi::AFTER_DRAIN) { E(acc, cur, wr, wc, fr, fq); S.done(cur); }
        if (!has_next) break;
#pragma unroll
        for (int a = 0; a < 2; ++a)
#pragma unroll
            for (int b = 0; b < 2; ++b)
#pragma unroll
                for (int m = 0; m < 4; ++m)
#pragma unroll
                    for (int n = 0; n < 2; ++n) acc[a][b][m][n] = (f32x4){0.f, 0.f, 0.f, 0.f};
        cur = nxt; cA = nA; cB = nB; ++ui;
        if constexpr (ALIGN_EPI) { if (wr == 1) PG8_BAR; }
    }
    PG8_WAIT_V(0);
    if constexpr (!ALIGN_EPI) { if (wr == 0) PG8_BAR; }
    PG8_BAR;
    if constexpr (Epi::AFTER_DRAIN) { E.fused(acc, cur, wr, wc, fr, fq, lds, wid, lane); S.done(cur); }
#undef PG8_SA
#undef PG8_SB
#undef PG8_STAGE
#undef PG8_LDA
#undef PG8_LDB
#undef PG8_MMA
#undef PG8_WAIT_V
#undef PG8_WAIT_L
#undef PG8_BAR
#undef PG8_SCHED
}
}

#define GAS __attribute__((address_space(1)))
#define LAS __attribute__((address_space(3)))
typedef unsigned short bf16;
typedef unsigned v4u __attribute__((ext_vector_type(4)));
typedef float f32x4 __attribute__((ext_vector_type(4)));
typedef short bf16x8 __attribute__((ext_vector_type(8)));
typedef GAS unsigned gu32;
typedef GAS unsigned long long gu64;
#define RLX_AGENT __ATOMIC_RELAXED, __HIP_MEMORY_SCOPE_AGENT
#define LDS_WAIT() asm volatile("s_waitcnt lgkmcnt(0)" ::: "memory")
#define VM_WAIT() asm volatile("s_waitcnt vmcnt(0)" ::: "memory")
__device__ __forceinline__ unsigned long long rt() { return __builtin_amdgcn_s_memrealtime(); }
__device__ __forceinline__ unsigned f2bf(float f) { unsigned u = __builtin_bit_cast(unsigned, f); return (u + 0x7fffu + ((u >> 16) & 1u)) >> 16; }
__device__ __forceinline__ unsigned pk2(float lo, float hi) { return f2bf(lo) | (f2bf(hi) << 16); }
#define XB_TMO      128
#define XB_XCNT(j)  (256  + 64 * (j))
#define XB_XSUB(j)  (1280 + 64 * (j))
#define XB_XGEN(j)  (2304 + 64 * (j))
#define XB_TOP      3328
#define XB_TOPGEN   3392
#define XCD_BAR_WORDS 3456
#define XB_SPIN_CAP (1u << 18)

__device__ __forceinline__ unsigned xb_ld(unsigned* p)              { return __hip_atomic_load(p, __ATOMIC_RELAXED, __HIP_MEMORY_SCOPE_AGENT); }
__device__ __forceinline__ unsigned xb_add(unsigned* p, unsigned v) { return __hip_atomic_fetch_add(p, v, __ATOMIC_RELAXED, __HIP_MEMORY_SCOPE_AGENT); }
__device__ __forceinline__ unsigned xb_xcc_id() { return (unsigned)__builtin_amdgcn_s_getreg((3 << 11) | 20) & 0xFu; }
#define XB_SPIN(cond, bar) do { unsigned _sp = 0; while (cond) { __builtin_amdgcn_s_sleep(1); \
    if ((++_sp & 255u) == 0u) { if (xb_ld(&(bar)[XB_TMO])) break; if (_sp > XB_SPIN_CAP) { atomicAdd(&(bar)[XB_TMO], 1u); break; } } } } while (0)

struct XcdBarrier {
    unsigned* bar; unsigned x;
    volatile LAS unsigned* st;
};

__device__ __forceinline__ XcdBarrier xcd_barrier_post(unsigned* bar, volatile LAS unsigned* st) {
    XcdBarrier b; b.bar = bar; b.x = xb_xcc_id(); b.st = st;
    if (threadIdx.x == 0) (void)xb_add(&bar[XB_XCNT(b.x)], 1u);
    return b;
}
__device__ __forceinline__ void xcd_barrier_complete(unsigned* bar, unsigned x, unsigned& nloc, unsigned& nx) {
    const unsigned G = gridDim.x * gridDim.y * gridDim.z;
    unsigned sum, cnt, mine, sp = 0u;
    for (;;) {
        sum = 0u; cnt = 0u; mine = 0u;
#pragma unroll
        for (unsigned j = 0; j < 16; ++j) { const unsigned c = xb_ld(&bar[XB_XCNT(j)]); sum += c; cnt += (c > 0u) ? 1u : 0u; mine = (j == x) ? c : mine; }
        if (sum == G) break;
        __builtin_amdgcn_s_sleep(1);
        if ((++sp & 255u) == 0u) { if (xb_ld(&bar[XB_TMO])) break; if (sp > XB_SPIN_CAP) { atomicAdd(&bar[XB_TMO], 1u); break; } }
    }
    nloc = mine > 0u ? mine : 1u; nx = cnt > 0u ? cnt : 1u;
}

__device__ __forceinline__ void xcd_barrier(const XcdBarrier& b) {
    asm volatile("s_waitcnt vmcnt(0)" ::: "memory");
    __syncthreads();
    if (threadIdx.x == 0) {
        unsigned* bar = b.bar;
        __builtin_amdgcn_s_waitcnt(0);
        unsigned nloc = b.st[0], nx = b.st[1];
        if (nloc == 0u) { xcd_barrier_complete(bar, b.x, nloc, nx); b.st[0] = nloc; b.st[1] = nx; }
        const unsigned old = xb_add(&bar[XB_XSUB(b.x)], 1u);
        const unsigned gen = old / nloc;
        if (old + 1u == (gen + 1u) * nloc) {
            __builtin_amdgcn_fence(__ATOMIC_RELEASE, "agent");
            asm volatile("s_waitcnt vmcnt(0)" ::: "memory");
            const unsigned og = xb_add(&bar[XB_TOP], 1u);
            const unsigned tg = og / nx;
            if (og + 1u == (tg + 1u) * nx) xb_add(&bar[XB_TOPGEN], 1u);
            else XB_SPIN(xb_ld(&bar[XB_TOPGEN]) == tg, bar);
            __builtin_amdgcn_fence(__ATOMIC_ACQUIRE, "agent");
            xb_add(&bar[XB_XGEN(b.x)], 1u);
            asm volatile("s_waitcnt vmcnt(0)" ::: "memory");
        } else {
            XB_SPIN(xb_ld(&bar[XB_XGEN(b.x)]) == gen, bar);
            __builtin_amdgcn_fence(__ATOMIC_ACQUIRE, "agent");
            asm volatile("s_waitcnt vmcnt(0)" ::: "memory");
        }
    }
    __syncthreads();
}


constexpr int DM = 1024, FFD = 4096, INW = 3328;
constexpr int SEQP = 2048, SEQS = 8192, NBP = 16, NBS = 2;
constexpr int RP = NBP * SEQP, RS = NBS * SEQS, R = RP + RS;
constexpr int NMETA = 16, LP = SEQP + NMETA, LS = SEQS + NMETA;
constexpr int N1P = 43, N2P = 48, N1S = 76, N2S = 108;
constexpr int UROWS = NBP * LP + NBS * LS;
constexpr float RMS_EPS = 1e-6f, LOG2E = 1.4426950408889634f, QSCALE = 0.125f * 1.4426950408889634f;
constexpr int WINDOW = 128;
#ifndef MK_N_LAUNCHES
#define MK_N_LAUNCHES 1
#endif
constexpr int N_PHASES = 10;

constexpr size_t MiB = 1u << 20;
constexpr size_t WS_CTL = 0, CTL_ZERO_BYTES = 1 * MiB;
constexpr size_t WS_WIN = 2 * MiB, WS_WAO = 9 * MiB, WS_WF = 10 * MiB, WS_WOUT = 12 * MiB, WS_WUP = 14 * MiB, WS_WDN = 22 * MiB;
constexpr size_t WS_SSQ1 = 2 * MiB;
constexpr size_t WS_ROPE = 30 * MiB;
constexpr size_t WS_TABLP = 30 * MiB + 640 * 1024, WS_TABLS = WS_TABLP + 32 * 1024, WS_TABN1P = WS_TABLP + 128 * 1024, WS_TABN1S = WS_TABLP + 132 * 1024;
constexpr size_t WS_KMETA = 31 * MiB, WS_VMETA = 31 * MiB + 4096;
constexpr size_t WS_G = 32 * MiB, WS_Q = 224 * MiB, WS_K = 272 * MiB, WS_V = 284 * MiB, WS_U = 296 * MiB, WS_A = 345 * MiB;
constexpr size_t WS_MERGED = 224 * MiB;
constexpr size_t WS_TT = 32 * MiB;
constexpr size_t WS_H = 416 * MiB;
constexpr size_t WS_END = 512 * MiB;
static_assert(WS_U + (size_t)UROWS * 512 * 2 <= WS_A && WS_A + (size_t)R * 512 * 2 <= WS_H && WS_TT + (size_t)R * FFD * 2 <= WS_H && WS_H + (size_t)R * DM * 2 <= WS_END, "d_ws map");
static_assert(WS_WIN + (size_t)INW * DM * 2 <= WS_WAO && WS_SSQ1 + (size_t)R * 16 * 4 <= WS_WAO, "d_ws map (weights)");
constexpr int CW_BAR = 4096;

constexpr int RING_BYTES = 131072, LDSCTL_OFF = RING_BYTES, MISC_OFF = LDSCTL_OFF + 320, TAB128_OFF = LDSCTL_OFF + 1024, LDS_BYTES = 147456;
constexpr int NWAVES = 8;

__device__ __forceinline__ float bf2f(unsigned short b) { return __builtin_bit_cast(float, (unsigned)b << 16); }
__device__ __forceinline__ float bflo(unsigned u) { return __builtin_bit_cast(float, u << 16); }
__device__ __forceinline__ float bfhi(unsigned u) { return __builtin_bit_cast(float, u & 0xffff0000u); }
__device__ __forceinline__ float wave_sum(float v) {
#pragma unroll
    for (int o = 1; o < 64; o <<= 1) v += __shfl_xor(v, o);
    return v;
}
__device__ __forceinline__ void row_decode(int r, int& seq, int& s, int& S) {
    if (r < RP) { seq = r >> 11; s = r & (SEQP - 1); S = SEQP; } else { const int q = r - RP; seq = NBP + (q >> 13); s = q & (SEQS - 1); S = SEQS; }
}
__device__ __forceinline__ int useq_base(int seq) { return seq < NBP ? seq * LP : NBP * LP + (seq - NBP) * LS; }
__device__ __forceinline__ int rseq_base(int seq) { return seq < NBP ? seq * SEQP : RP + (seq - NBP) * SEQS; }
__device__ __forceinline__ float sigmoidf_fast(float x) { return __builtin_amdgcn_rcpf(1.0f + __builtin_amdgcn_exp2f(-x * LOG2E)); }

typedef pg8::u32x4 u32x4; using pg8::Unit; typedef pg8::bf16_t bf16_t; using pg8::cvt_pk_bf16;
__device__ __forceinline__ u32x4 pack8(const f32x4 a, const f32x4 b) { u32x4 w; w.x = cvt_pk_bf16(a[0], a[1]); w.y = cvt_pk_bf16(a[2], a[3]); w.z = cvt_pk_bf16(b[0], b[1]); w.w = cvt_pk_bf16(b[2], b[3]); return w; }

struct EpiIn {
    static constexpr bool PERM = true, AFTER_DRAIN = false;
    bf16_t *Q, *K, *V, *U, *G; const float* bgate; const float* rope;
    __device__ __forceinline__ void operator()(const f32x4 (&acc)[2][2][4][2], const Unit& u, int wr, int wc, int fr, int fq) const {
        const int pn = u.pn, rowt = u.pm * 256;
        int seq, s0, S; row_decode(rowt, seq, s0, S);
        const int ub = useq_base(seq) + NMETA + s0 - rowt;
        const int lane = fr + 16 * fq;
#pragma unroll
        for (int ai = 0; ai < 2; ++ai)
#pragma unroll
            for (int m = 0; m < 4; ++m) {
                const int rl = ai * 128 + wr * 64 + m * 16 + fr, row = rowt + rl;
#pragma unroll
                for (int bj = 0; bj < 2; ++bj) {
                    f32x4 v0 = acc[ai][bj][m][0], v1 = acc[ai][bj][m][1];
                    const int cc = bj * 128 + wc * 32 + 8 * fq;
                    if (pn < 3 && !(pn == 2 && bj == 1)) {
                        if ((wc & 1) == 0) {
                            f32x4 o0, o1;
#pragma unroll
                            for (int j = 0; j < 4; ++j) { o0[j] = __shfl_xor(v0[j], 16); o1[j] = __shfl_xor(v1[j], 16); }
                            if (fq < 2) {
                                const float* rp = rope + (size_t)(NMETA + s0 + rl) * 16;
                                const f32x4 c0 = *(const f32x4*)(rp), c1 = *(const f32x4*)(rp + 4), s0v = *(const f32x4*)(rp + 8), s1v = *(const f32x4*)(rp + 12);
                                const float sg = (fq == 0) ? -1.f : 1.f;
                                v0 = v0 * c0 + (o0 * s0v) * sg; v1 = v1 * c1 + (o1 * s1v) * sg;
                            }
                        }
                        if (pn < 2) { v0 = v0 * QSCALE; v1 = v1 * QSCALE; *(u32x4*)(Q + (size_t)row * 512 + pn * 256 + cc) = pack8(v0, v1); }
                        else *(u32x4*)(K + (size_t)row * 128 + cc) = pack8(v0, v1);
                    } else if (pn == 2) {
                        *(u32x4*)(V + (size_t)row * 128 + (cc - 128)) = pack8(v0, v1);
                    } else if (pn < 5) {
                        *(u32x4*)(U + (size_t)(ub + row) * 512 + (pn - 3) * 256 + cc) = pack8(v0, v1);
                    } else {
                        const int gc = (pn - 5) * 256 + cc;
                        const f32x4 b0 = *(const f32x4*)(bgate + gc), b1 = *(const f32x4*)(bgate + gc + 4);
#pragma unroll
                        for (int j = 0; j < 4; ++j) { v0[j] = sigmoidf_fast(v0[j] + b0[j]); v1[j] = sigmoidf_fast(v1[j] + b1[j]); }
                        *(u32x4*)(G + (size_t)row * 2048 + gc) = pack8(v0, v1);
                    }
                }
            }
        (void)lane;
    }
};
struct EpiAO {
    static constexpr bool PERM = true, AFTER_DRAIN = false;
    const bf16_t* G; float* tmp;
    __device__ __forceinline__ void operator()(const f32x4 (&acc)[2][2][4][2], const Unit& u, int wr, int wc, int fr, int fq) const {
#pragma unroll
        for (int ai = 0; ai < 2; ++ai)
#pragma unroll
            for (int m = 0; m < 4; ++m) {
                const int row = u.pm * 256 + ai * 128 + wr * 64 + m * 16 + fr;
#pragma unroll
                for (int bj = 0; bj < 2; ++bj) {
                    const int col = u.pn * 256 + bj * 128 + wc * 32 + 8 * fq;
                    const u32x4 g = *(const u32x4*)(G + (size_t)row * 2048 + col);
                    const f32x4 g0 = {bflo(g.x), bfhi(g.x), bflo(g.y), bfhi(g.y)}, g1 = {bflo(g.z), bfhi(g.z), bflo(g.w), bfhi(g.w)};
                    float* tp = tmp + (size_t)row * DM + col;
                    *(f32x4*)tp = acc[ai][bj][m][0] * g0; *(f32x4*)(tp + 4) = acc[ai][bj][m][1] * g1;
                }
            }
    }
};
struct EpiF {
    static constexpr bool PERM = true, AFTER_DRAIN = false;
    const bf16_t* G; const float* tmp; bf16_t* MG;
    __device__ __forceinline__ void operator()(const f32x4 (&acc)[2][2][4][2], const Unit& u, int wr, int wc, int fr, int fq) const {
#pragma unroll
        for (int ai = 0; ai < 2; ++ai)
#pragma unroll
            for (int m = 0; m < 4; ++m) {
                const int row = u.pm * 256 + ai * 128 + wr * 64 + m * 16 + fr;
#pragma unroll
                for (int bj = 0; bj < 2; ++bj) {
                    const int col = u.pn * 256 + bj * 128 + wc * 32 + 8 * fq;
                    const u32x4 g = *(const u32x4*)(G + (size_t)row * 2048 + 1024 + col);
                    const f32x4 g0 = {bflo(g.x), bfhi(g.x), bflo(g.y), bfhi(g.y)}, g1 = {bflo(g.z), bfhi(g.z), bflo(g.w), bfhi(g.w)};
                    const float* tp = tmp + (size_t)row * DM + col;
                    const f32x4 t0 = *(const f32x4*)tp, t1 = *(const f32x4*)(tp + 4);
                    *(u32x4*)(MG + (size_t)row * DM + col) = pack8(t0 + acc[ai][bj][m][0] * g0, t1 + acc[ai][bj][m][1] * g1);
                }
            }
    }
};
struct EpiOut {
    static constexpr bool PERM = true, AFTER_DRAIN = false;
    const float *xp, *xs; float* h1; bf16_t* H1B; float* ssq;
    __device__ __forceinline__ void operator()(const f32x4 (&acc)[2][2][4][2], const Unit& u, int wr, int wc, int fr, int fq) const {
#pragma unroll
        for (int ai = 0; ai < 2; ++ai)
#pragma unroll
            for (int m = 0; m < 4; ++m) {
                const int row = u.pm * 256 + ai * 128 + wr * 64 + m * 16 + fr;
                const float* xr = (row < RP) ? xp + (size_t)row * DM : xs + (size_t)(row - RP) * DM;
                float sq = 0.f;
#pragma unroll
                for (int bj = 0; bj < 2; ++bj) {
                    const int col = u.pn * 256 + bj * 128 + wc * 32 + 8 * fq;
                    const f32x4 a0 = *(const f32x4*)(xr + col) + acc[ai][bj][m][0], a1 = *(const f32x4*)(xr + col + 4) + acc[ai][bj][m][1];
                    float* hp = h1 + (size_t)row * DM + col; *(f32x4*)hp = a0; *(f32x4*)(hp + 4) = a1;
                    *(u32x4*)(H1B + (size_t)row * DM + col) = pack8(a0, a1);
                    sq += (a0[0] * a0[0] + a0[1] * a0[1]) + (a0[2] * a0[2] + a0[3] * a0[3]) + (a1[0] * a1[0] + a1[1] * a1[1]) + (a1[2] * a1[2] + a1[3] * a1[3]);
                }
                sq += __shfl_xor(sq, 16); sq += __shfl_xor(sq, 32);
                if (fq == 0) ssq[(size_t)row * 16 + u.pn * 4 + wc] = sq;
            }
    }
};
struct EpiUp {
    static constexpr bool PERM = true, AFTER_DRAIN = false;
    const float* ssq; bf16_t* TT;
    __device__ __forceinline__ void operator()(const f32x4 (&acc)[2][2][4][2], const Unit& u, int wr, int wc, int fr, int fq) const {
#pragma unroll
        for (int ai = 0; ai < 2; ++ai)
#pragma unroll
            for (int m = 0; m < 4; ++m) {
                const int row = u.pm * 256 + ai * 128 + wr * 64 + m * 16 + fr;
                const float* sp = ssq + (size_t)row * 16;
                const f32x4 p0 = *(const f32x4*)sp, p1 = *(const f32x4*)(sp + 4), p2 = *(const f32x4*)(sp + 8), p3 = *(const f32x4*)(sp + 12);
                const float tot = (((p0[0] + p0[1]) + (p0[2] + p0[3])) + ((p1[0] + p1[1]) + (p1[2] + p1[3]))) + (((p2[0] + p2[1]) + (p2[2] + p2[3])) + ((p3[0] + p3[1]) + (p3[2] + p3[3])));
                const float rinv = 1.0f / sqrtf(tot * (1.0f / DM) + RMS_EPS);
#pragma unroll
                for (int bj = 0; bj < 2; ++bj) {
                    const int col = u.pn * 256 + bj * 128 + wc * 32 + 8 * fq;
                    f32x4 a0 = acc[ai][bj][m][0] * rinv, a1 = acc[ai][bj][m][1] * rinv;
#pragma unroll
                    for (int j = 0; j < 4; ++j) { a0[j] = fmaxf(a0[j], 0.f); a0[j] *= a0[j]; a1[j] = fmaxf(a1[j], 0.f); a1[j] *= a1[j]; }
                    *(u32x4*)(TT + (size_t)row * FFD + col) = pack8(a0, a1);
                }
            }
    }
};
struct EpiDown {
    static constexpr bool PERM = true, AFTER_DRAIN = false;
    float* h;
    __device__ __forceinline__ void operator()(const f32x4 (&acc)[2][2][4][2], const Unit& u, int wr, int wc, int fr, int fq) const {
#pragma unroll
        for (int ai = 0; ai < 2; ++ai)
#pragma unroll
            for (int m = 0; m < 4; ++m) {
                const int row = u.pm * 256 + ai * 128 + wr * 64 + m * 16 + fr;
#pragma unroll
                for (int bj = 0; bj < 2; ++bj) {
                    const int col = u.pn * 256 + bj * 128 + wc * 32 + 8 * fq;
                    float* hp = h + (size_t)row * DM + col;
                    const f32x4 a0 = *(const f32x4*)hp + acc[ai][bj][m][0], a1 = *(const f32x4*)(hp + 4) + acc[ai][bj][m][1];
                    *(f32x4*)hp = a0; *(f32x4*)(hp + 4) = a1;
                }
            }
    }
};

__device__ __forceinline__ void p0_transpose_item(const float* W, int K, int N, bf16* WT, const float* gk, LAS float* scr, int item, int lane) {
    const int nblk = N / 32, kb = item / nblk, nb = item % nblk, k0 = 64 * kb, n0 = 32 * nb;
#pragma unroll 8
    for (int i = 0; i < 32; ++i) { const int kk = 2 * i + (lane >> 5); float w = W[(size_t)(k0 + kk) * N + n0 + (lane & 31)]; if (gk) w *= gk[k0 + kk]; scr[kk * 33 + (lane & 31)] = w; }
    LDS_WAIT(); asm volatile("" ::: "memory");
    const int c = lane & 7;
#pragma unroll
    for (int j = 0; j < 4; ++j) { const int n = (lane >> 3) + 8 * j; const LAS float* s = scr + (8 * c) * 33 + n;
        v4u o; o.x = pk2(s[0 * 33], s[1 * 33]); o.y = pk2(s[2 * 33], s[3 * 33]); o.z = pk2(s[4 * 33], s[5 * 33]); o.w = pk2(s[6 * 33], s[7 * 33]);
        *(GAS v4u*)(WT + (size_t)(n0 + n) * K + k0 + 8 * c) = o; }
    LDS_WAIT(); asm volatile("" ::: "memory");
}
__device__ __forceinline__ float rope_invfreq(int i) { return powf(500000.0f, -(float)i / 8.0f); }

struct Ptrs {
    const float *xp, *xs, *meta, *gmix, *win, *bgate, *sink, *wao, *wf, *wout, *gmlp, *wup, *wdn, *gfin; float* out;
    bf16 *WinT, *WaoT, *WfT, *WoutT, *WupT, *WdnT, *Gt, *Q, *K, *V, *U, *A, *MG, *TT, *XN, *AB, *H1B, *Km, *Vm, *Y;
    float *ssq1, *rope; float2 *tabLP, *tabLS, *tabN1P, *tabN1S;
};

__device__ __forceinline__ void p0_prologue(const Ptrs& P, LAS unsigned char* lds, int vcu, int G, int tid, int lane, int wave) {
    LAS float* scr = (LAS float*)(lds + wave * 16384);
    LAS float* t128 = (LAS float*)(lds + TAB128_OFF);
    if (tid < 128) { t128[tid] = cospif((float)tid / 64.0f); t128[128 + tid] = sinpif((float)tid / 64.0f); }
    __syncthreads();
    const int gw = vcu * NWAVES + wave, NGW = G * NWAVES;
    constexpr int I_IN = (DM / 64) * (INW / 32), I_AO = (512 / 64) * (DM / 32), I_OUT = (DM / 64) * (DM / 32), I_UP = (DM / 64) * (FFD / 32), I_DN = (FFD / 64) * (DM / 32);
    constexpr int NT_ITEMS = I_IN + I_AO + I_OUT + I_UP + I_DN;
    for (int it = gw; it < NT_ITEMS; it += NGW) {
        int r = it;
        if (r < I_IN) { p0_transpose_item(P.win, DM, INW, P.WinT, nullptr, scr, r, lane); continue; } r -= I_IN;
        if (r < I_AO) { p0_transpose_item(P.wao, 512, DM, P.WaoT, nullptr, scr, r, lane); continue; } r -= I_AO;
        if (r < I_OUT) { p0_transpose_item(P.wout, DM, DM, P.WoutT, nullptr, scr, r, lane); continue; } r -= I_OUT;
        if (r < I_UP) { p0_transpose_item(P.wup, DM, FFD, P.WupT, P.gmlp, scr, r, lane); continue; } r -= I_UP;
        p0_transpose_item(P.wdn, FFD, DM, P.WdnT, nullptr, scr, r, lane);
    }
    for (int it = gw; it < 16 * 1024; it += NGW) {
        const int nb = it & 15, kk = it >> 4, part = kk >> 9, g = (kk >> 7) & 3, c = kk & 127, n = nb * 64 + lane;
        const float* wp = P.wf + (size_t)(g * 128) * DM + n; const LAS float* tb = t128 + part * 128;
        float a = 0.f;
#pragma unroll 16
        for (int m = 0; m < 128; ++m) a += tb[(c * m) & 127] * wp[(size_t)m * DM];
        a *= 0.08838834764831845f; if (part) a = -a;
        P.WfT[(size_t)n * DM + kk] = (bf16)f2bf(a);
    }
    for (int r = gw; r < R; r += NGW) {
        const float* xr = (r < RP) ? P.xp + (size_t)r * DM : P.xs + (size_t)(r - RP) * DM;
        const GAS f32x4* x4 = (const GAS f32x4*)xr + lane; const GAS f32x4* g4 = (const GAS f32x4*)P.gmix + lane;
        f32x4 v[4]; float s = 0.f;
#pragma unroll
        for (int j = 0; j < 4; ++j) { v[j] = x4[64 * j]; s += (v[j].x * v[j].x + v[j].y * v[j].y) + (v[j].z * v[j].z + v[j].w * v[j].w); }
        const float rinv = 1.0f / sqrtf(wave_sum(s) * (1.0f / DM) + RMS_EPS);
        GAS unsigned long long* o8 = (GAS unsigned long long*)(P.XN + (size_t)r * DM) + lane;
#pragma unroll
        for (int j = 0; j < 4; ++j) { const f32x4 gg = g4[64 * j]; const f32x4 y = v[j] * rinv * gg;
            o8[64 * j] = (unsigned long long)pk2(y.x, y.y) | ((unsigned long long)pk2(y.z, y.w) << 32); }
    }
    for (int it = gw; it < 16 * 12; it += NGW) {
        const int m = it / 12, cb = it % 12;
        { const float* mr = P.meta + (size_t)m * DM; float s = 0.f; float xv[16];
#pragma unroll
          for (int j = 0; j < 16; ++j) { xv[j] = mr[lane + 64 * j]; s += xv[j] * xv[j]; }
          const float rinv = 1.0f / sqrtf(wave_sum(s) * (1.0f / DM) + RMS_EPS);
#pragma unroll
          for (int j = 0; j < 16; ++j) scr[lane + 64 * j] = xv[j] * rinv * P.gmix[lane + 64 * j];
          LDS_WAIT(); asm volatile("" ::: "memory"); }
        const int col = 512 + cb * 64 + lane; const float* wp = P.win + col;
        float a = 0.f;
#pragma unroll 32
        for (int k = 0; k < DM; ++k) a += scr[k] * wp[(size_t)k * INW];
        LDS_WAIT(); asm volatile("" ::: "memory");
        if (cb < 2) {
            const float o = __shfl_xor(a, 8);
            if (lane < 16) { const float ang = (float)m * rope_invfreq(lane & 7); const float cs = cosf(ang), sn = sinf(ang); a = (lane < 8) ? a * cs - o * sn : a * cs + o * sn; }
            P.Km[m * 128 + cb * 64 + lane] = (bf16)f2bf(a);
        } else if (cb < 4) {
            P.Vm[m * 128 + (cb - 2) * 64 + lane] = (bf16)f2bf(a);
        } else {
            const bf16 ub = (bf16)f2bf(a);
            for (int sq = 0; sq < NBP + NBS; ++sq) P.U[(size_t)(useq_base(sq) + m) * 512 + (cb - 4) * 64 + lane] = ub;
        }
    }
    const int gt = (vcu * NWAVES + wave) * 64 + lane, NGT = G * NWAVES * 64;
    for (int e = gt; e < LS * 8; e += NGT) { const int pos = e >> 3, i = e & 7; const float ang = (float)pos * rope_invfreq(i); P.rope[pos * 16 + i] = cosf(ang); P.rope[pos * 16 + 8 + i] = sinf(ang); }
    for (int e = gt; e < LP; e += NGT) { const float t = 2.0f * (float)e / (float)LP; P.tabLP[e] = make_float2(cospif(t), sinpif(t)); }
    for (int e = gt; e < LS; e += NGT) { const float t = 2.0f * (float)e / (float)LS; P.tabLS[e] = make_float2(cospif(t), sinpif(t)); }
    for (int e = gt; e < N1P; e += NGT) { const float t = 2.0f * (float)e / (float)N1P; P.tabN1P[e] = make_float2(cospif(t), sinpif(t)); }
    for (int e = gt; e < N1S; e += NGT) { const float t = 2.0f * (float)e / (float)N1S; P.tabN1S[e] = make_float2(cospif(t), sinpif(t)); }
}

__device__ __forceinline__ void attn_key(const bf16* kr, const bf16* vr, bool valid, const float (&q)[64], float (&o)[64], float& m, float& l) {
    float s = 0.f;
#pragma unroll
    for (int c = 0; c < 8; ++c) { const v4u kk = *(const v4u*)(kr + 8 * c);
        s += q[8 * c + 0] * bflo(kk.x) + q[8 * c + 1] * bfhi(kk.x) + q[8 * c + 2] * bflo(kk.y) + q[8 * c + 3] * bfhi(kk.y)
           + q[8 * c + 4] * bflo(kk.z) + q[8 * c + 5] * bfhi(kk.z) + q[8 * c + 6] * bflo(kk.w) + q[8 * c + 7] * bfhi(kk.w); }
    if (!valid) s = -INFINITY;
    const float mn = fmaxf(m, s), a = __builtin_amdgcn_exp2f(m - mn), p = __builtin_amdgcn_exp2f(s - mn);
    l = l * a + p; m = mn;
#pragma unroll
    for (int c = 0; c < 8; ++c) { const v4u vv = *(const v4u*)(vr + 8 * c);
        o[8 * c + 0] = o[8 * c + 0] * a + p * bflo(vv.x); o[8 * c + 1] = o[8 * c + 1] * a + p * bfhi(vv.x);
        o[8 * c + 2] = o[8 * c + 2] * a + p * bflo(vv.y); o[8 * c + 3] = o[8 * c + 3] * a + p * bfhi(vv.y);
        o[8 * c + 4] = o[8 * c + 4] * a + p * bflo(vv.z); o[8 * c + 5] = o[8 * c + 5] * a + p * bfhi(vv.z);
        o[8 * c + 6] = o[8 * c + 6] * a + p * bflo(vv.w); o[8 * c + 7] = o[8 * c + 7] * a + p * bfhi(vv.w); }
}
__device__ __forceinline__ void attn_scalar(const Ptrs& P, int gw, int NGW, int lane) {
    for (int it = gw; it < 8 * (R / 64); it += NGW) {
        const int h = it & 7, tb = it >> 3, hk = h >> 2, r = tb * 64 + lane;
        int seq, s, S; row_decode(r, seq, s, S); const int rb = rseq_base(seq);
        float q[64], o[64];
#pragma unroll
        for (int c = 0; c < 8; ++c) { const v4u qq = *(const v4u*)(P.Q + (size_t)r * 512 + h * 64 + 8 * c);
            q[8 * c + 0] = bflo(qq.x); q[8 * c + 1] = bfhi(qq.x); q[8 * c + 2] = bflo(qq.y); q[8 * c + 3] = bfhi(qq.y);
            q[8 * c + 4] = bflo(qq.z); q[8 * c + 5] = bfhi(qq.z); q[8 * c + 6] = bflo(qq.w); q[8 * c + 7] = bfhi(qq.w); }
#pragma unroll
        for (int d = 0; d < 64; ++d) o[d] = 0.f;
        float m = P.sink[h] * LOG2E, l = 1.0f;
        for (int j = 0; j < NMETA; ++j) attn_key(P.Km + j * 128 + hk * 64, P.Vm + j * 128 + hk * 64, true, q, o, m, l);
        for (int dj = -WINDOW; dj <= WINDOW; ++dj) {
            const int sp = s + dj; const bool valid = (sp >= 0) && (sp < S); const int spc = sp < 0 ? 0 : (sp >= S ? S - 1 : sp);
            attn_key(P.K + (size_t)(rb + spc) * 128 + hk * 64, P.V + (size_t)(rb + spc) * 128 + hk * 64, valid, q, o, m, l);
        }
        const float il = 1.0f / l;
#pragma unroll
        for (int c = 0; c < 8; ++c) { v4u w; w.x = pk2(o[8 * c + 0] * il, o[8 * c + 1] * il); w.y = pk2(o[8 * c + 2] * il, o[8 * c + 3] * il); w.z = pk2(o[8 * c + 4] * il, o[8 * c + 5] * il); w.w = pk2(o[8 * c + 6] * il, o[8 * c + 7] * il);
            *(v4u*)(P.A + (size_t)r * 512 + h * 64 + 8 * c) = w; }
    }
}


typedef float f32x16 __attribute__((ext_vector_type(16)));
typedef short v4i16_t __attribute__((ext_vector_type(4)));
constexpr int AT_KW = 0, AT_VW = 320 * 128, AT_KM = 2 * 320 * 128, AT_VM = AT_KM + 32 * 128;
__device__ __forceinline__ bf16x8 tr_frag(LAS unsigned char* p) {
    const v4i16_t lo = __builtin_amdgcn_ds_read_tr16_b64_v4i16((LAS v4i16_t*)p), hi = __builtin_amdgcn_ds_read_tr16_b64_v4i16((LAS v4i16_t*)(p + 8 * 128));
    return (bf16x8){lo[0], lo[1], lo[2], lo[3], hi[0], hi[1], hi[2], hi[3]};
}
__device__ __forceinline__ void attn_tile(LAS unsigned char* kt, LAS unsigned char* vt, const int mode, const bf16x8 (&qf)[4], f32x16& o0, f32x16& o1, float& m, float& l, const int lane) {
    const int r32 = lane & 31, hi = lane >> 5;
    f32x16 p;
#pragma unroll
    for (int i = 0; i < 16; ++i) p[i] = 0.f;
#pragma unroll
    for (int st = 0; st < 4; ++st) {
        const bf16x8 kf = *(const LAS bf16x8*)(kt + r32 * 128 + (((2 * st + hi) ^ (r32 & 7)) << 4));
        p = __builtin_amdgcn_mfma_f32_32x32x16_bf16(kf, qf[st], p, 0, 0, 0);
    }
    if (mode) {
#pragma unroll
        for (int i = 0; i < 16; ++i) { const int kk = (i & 3) + 8 * (i >> 2) + 4 * hi;
            const bool msk = (mode == 1) ? (kk < r32) : ((mode == 2) ? (kk > r32) : (kk >= 16));
            if (msk) p[i] = -INFINITY; }
    }
    float tm = p[0];
#pragma unroll
    for (int i = 1; i < 16; ++i) tm = fmaxf(tm, p[i]);
    tm = fmaxf(tm, __shfl_xor(tm, 32));
    const float mn = fmaxf(m, tm), a = __builtin_amdgcn_exp2f(m - mn);
    m = mn;
    float ps = 0.f;
#pragma unroll
    for (int i = 0; i < 16; ++i) { p[i] = __builtin_amdgcn_exp2f(p[i] - mn); ps += p[i]; }
    l = l * a + ps;
#pragma unroll
    for (int i = 0; i < 16; ++i) { o0[i] *= a; o1[i] *= a; }
    u32x4 w0, w1;
    w0.x = cvt_pk_bf16(p[0], p[1]); w0.y = cvt_pk_bf16(p[2], p[3]); w0.z = cvt_pk_bf16(p[4], p[5]); w0.w = cvt_pk_bf16(p[6], p[7]);
    w1.x = cvt_pk_bf16(p[8], p[9]); w1.y = cvt_pk_bf16(p[10], p[11]); w1.z = cvt_pk_bf16(p[12], p[13]); w1.w = cvt_pk_bf16(p[14], p[15]);
    const bf16x8 pb0 = __builtin_bit_cast(bf16x8, w0), pb1 = __builtin_bit_cast(bf16x8, w1);
    LAS unsigned char* vb = vt + (4 * hi + ((lane & 15) >> 2)) * 128 + (16 * ((lane >> 4) & 1) + 4 * (lane & 3)) * 2;
    o0 = __builtin_amdgcn_mfma_f32_32x32x16_bf16(tr_frag(vb), pb0, o0, 0, 0, 0);
    o1 = __builtin_amdgcn_mfma_f32_32x32x16_bf16(tr_frag(vb + 64), pb0, o1, 0, 0, 0);
    o0 = __builtin_amdgcn_mfma_f32_32x32x16_bf16(tr_frag(vb + 16 * 128), pb1, o0, 0, 0, 0);
    o1 = __builtin_amdgcn_mfma_f32_32x32x16_bf16(tr_frag(vb + 16 * 128 + 64), pb1, o1, 0, 0, 0);
}
__device__ __forceinline__ void attn_mfma(const Ptrs& P, LAS unsigned char* lds, int vcu, int G, int tid, int lane, int wave) {
    constexpr int NU_P = NBP * 2 * (SEQP / 64), NU = (R / 64) * 2;
    for (int unit = vcu; unit < NU; unit += G) {
        int seq, hk, blk, S;
        if (unit < NU_P) { seq = unit >> 6; hk = (unit >> 5) & 1; blk = unit & 31; S = SEQP; }
        else { const int u2 = unit - NU_P; seq = NBP + (u2 >> 8); hk = (u2 >> 7) & 1; blk = u2 & 127; S = SEQS; }
        const int rb = rseq_base(seq), kw0 = blk * 64 - 128;
        for (int idx = tid; idx < 320 * 8; idx += NWAVES * 64) { const int kl = idx >> 3, c = idx & 7, key = kw0 + kl;
            if (key >= 0 && key < S) { const size_t go = (size_t)(rb + key) * 128 + hk * 64 + c * 8;
                const v4u kv = *(const v4u*)(P.K + go), vv = *(const v4u*)(P.V + go);
                *(LAS v4u*)(lds + AT_KW + kl * 128 + ((c ^ (kl & 7)) << 4)) = kv; *(LAS v4u*)(lds + AT_VW + kl * 128 + (c << 4)) = vv; } }
        if (tid < 256) { const int j = tid >> 3, c = tid & 7; v4u kv = {0u, 0u, 0u, 0u}, vv = {0u, 0u, 0u, 0u};
            if (j < NMETA) { kv = *(const v4u*)(P.Km + j * 128 + hk * 64 + c * 8); vv = *(const v4u*)(P.Vm + j * 128 + hk * 64 + c * 8); }
            *(LAS v4u*)(lds + AT_KM + j * 128 + ((c ^ (j & 7)) << 4)) = kv; *(LAS v4u*)(lds + AT_VM + j * 128 + (c << 4)) = vv; }
        __syncthreads();
        {
            const int g = wave >> 1, half = wave & 1, hq = hk * 4 + g, r32 = lane & 31, hi = lane >> 5;
            const int q0 = blk * 64 + half * 32;
            const size_t qrow = (size_t)(rb + q0 + r32);
            bf16x8 qf[4];
#pragma unroll
            for (int st = 0; st < 4; ++st) qf[st] = *(const bf16x8*)(P.Q + qrow * 512 + hq * 64 + 16 * st + 8 * hi);
            float m = P.sink[hq] * LOG2E, l = hi ? 0.f : 1.f;
            f32x16 o0, o1;
#pragma unroll
            for (int i = 0; i < 16; ++i) { o0[i] = 0.f; o1[i] = 0.f; }
            attn_tile(lds + AT_KM, lds + AT_VM, 3, qf, o0, o1, m, l, lane);
            for (int j = 0; j < 9; ++j) {
                const int key0 = q0 - 128 + 32 * j;
                if (key0 < 0 || key0 >= S) continue;
                const int kl0 = key0 - kw0;
                attn_tile(lds + AT_KW + kl0 * 128, lds + AT_VW + kl0 * 128, j == 0 ? 1 : (j == 8 ? 2 : 0), qf, o0, o1, m, l, lane);
            }
            l += __shfl_xor(l, 32);
            const float il = 1.0f / l;
            bf16* op = P.A + qrow * 512 + hq * 64 + 4 * hi;
#pragma unroll
            for (int rg = 0; rg < 4; ++rg) {
                uint2 w; w.x = cvt_pk_bf16(o0[4 * rg] * il, o0[4 * rg + 1] * il); w.y = cvt_pk_bf16(o0[4 * rg + 2] * il, o0[4 * rg + 3] * il); *(uint2*)(op + 8 * rg) = w;
                uint2 x; x.x = cvt_pk_bf16(o1[4 * rg] * il, o1[4 * rg + 1] * il); x.y = cvt_pk_bf16(o1[4 * rg + 2] * il, o1[4 * rg + 3] * il); *(uint2*)(op + 32 + 8 * rg) = x;
            }
        }
        __syncthreads();
    }
}

template <int N1, int N2>
__device__ __forceinline__ void fft1_scalar(const bf16* U, bf16* Y, const float2* tab, int seq0, int nseq, int wg, int G, int tid) {
    for (int it = wg; it < nseq * N2; it += G) {
        const int seq = seq0 + it / N2, l2 = it % N2, col = tid;
        const bf16* ub = U + (size_t)useq_base(seq) * 512; bf16* yb = Y + (size_t)useq_base(seq) * 1024;
        float u[N1];
#pragma unroll
        for (int l1 = 0; l1 < N1; ++l1) u[l1] = bf2f(ub[(size_t)(l1 * N2 + l2) * 512 + col]);
        for (int k1 = 0; k1 < N1; ++k1) {
            float ar = 0.f, ai = 0.f; int idx = 0;
#pragma unroll
            for (int l1 = 0; l1 < N1; ++l1) { const float2 t = tab[idx]; ar += u[l1] * t.x; ai -= u[l1] * t.y; idx += k1; if (idx >= N1) idx -= N1; }
            yb[(size_t)((0 * N1 + k1) * N2 + l2) * 512 + col] = (bf16)f2bf(ar);
            yb[(size_t)((1 * N1 + k1) * N2 + l2) * 512 + col] = (bf16)f2bf(ai);
        }
    }
}
template <int N1, int N2>
__device__ __forceinline__ void fft2_scalar(const bf16* Y, bf16* AB, const float2* tab, int L, int seq0, int nseq, LAS unsigned char* lds, int wg, int G, int tid) {
    const float isl = 1.0f / sqrtf((float)L);
    for (int it = wg; it < nseq * N1 * 2; it += G) {
        const int half = it & 1, k1 = (it >> 1) % N1, seq = seq0 + (it >> 1) / N1;
        const bf16* yb = Y + (size_t)useq_base(seq) * 1024;
        for (int idx = tid; idx < 2 * N2 * 32; idx += NWAVES * 64) { const int row = idx >> 5, ch = idx & 31, ri = row / N2, l2 = row % N2;
            *(LAS v4u*)(lds + row * 512 + ch * 16) = *(const v4u*)(yb + (size_t)((ri * N1 + k1) * N2 + l2) * 512 + half * 256 + ch * 8); }
        __syncthreads();
        const int col = tid & 255, kh = __builtin_amdgcn_readfirstlane(tid >> 8);
        const LAS bf16* sl = (const LAS bf16*)lds;
        for (int k2 = kh * (N2 / 2); k2 < (kh + 1) * (N2 / 2); ++k2) {
            const int k = k1 + N1 * k2; float a = 0.f, b = 0.f; int ix = 0;
            for (int l2 = 0; l2 < N2; ++l2) { const float yr = bf2f(sl[l2 * 256 + col]), yi = bf2f(sl[(N2 + l2) * 256 + col]); const float2 t = tab[ix];
                a += yr * t.x + yi * t.y; b += yr * t.y - yi * t.x; ix += k; if (ix >= L) ix -= L; }
            if (k >= NMETA) { const size_t r = (size_t)(rseq_base(seq) + k - NMETA);
                AB[r * 1024 + half * 256 + col] = (bf16)f2bf(a * isl); AB[r * 1024 + 512 + half * 256 + col] = (bf16)f2bf(b * isl); }
        }
        __syncthreads();
    }
}

struct Args { const float* in[14]; float* out; unsigned char* ws; int ph_lo, ph_hi; };
__global__ void __launch_bounds__(NWAVES * 64, 2) mk_fwd(Args args) {
    extern __shared__ __attribute__((aligned(16))) unsigned char lds_raw[];
    LAS unsigned char* lds = (LAS unsigned char*)lds_raw;
    volatile LAS unsigned* MISC = (volatile LAS unsigned*)(lds + MISC_OFF);
    const int tid = threadIdx.x, lane = tid & 63, wave = __builtin_amdgcn_readfirstlane(tid >> 6);
    const int G = gridDim.x, bx = blockIdx.x, vcu = (G % 8 == 0) ? (bx % 8) * (G / 8) + bx / 8 : bx;
    unsigned char* ws = args.ws;
    gu32* ctl = (gu32*)(ws + WS_CTL);
    Ptrs P;
    P.xp = args.in[0]; P.xs = args.in[1]; P.meta = args.in[2]; P.gmix = args.in[3]; P.win = args.in[4]; P.bgate = args.in[5]; P.sink = args.in[6]; P.wao = args.in[7];
    P.wf = args.in[8]; P.wout = args.in[9]; P.gmlp = args.in[10]; P.wup = args.in[11]; P.wdn = args.in[12]; P.gfin = args.in[13]; P.out = args.out;
    P.WinT = (bf16*)(ws + WS_WIN); P.WaoT = (bf16*)(ws + WS_WAO); P.WfT = (bf16*)(ws + WS_WF); P.WoutT = (bf16*)(ws + WS_WOUT); P.WupT = (bf16*)(ws + WS_WUP); P.WdnT = (bf16*)(ws + WS_WDN);
    P.Gt = (bf16*)(ws + WS_G); P.Q = (bf16*)(ws + WS_Q); P.K = (bf16*)(ws + WS_K); P.V = (bf16*)(ws + WS_V); P.U = (bf16*)(ws + WS_U); P.A = (bf16*)(ws + WS_A);
    P.MG = (bf16*)(ws + WS_MERGED); P.TT = (bf16*)(ws + WS_TT); P.XN = (bf16*)(ws + WS_H); P.AB = (bf16*)(ws + WS_H); P.H1B = (bf16*)(ws + WS_H);
    P.Km = (bf16*)(ws + WS_KMETA); P.Vm = (bf16*)(ws + WS_VMETA); P.Y = (bf16*)args.out;
    P.ssq1 = (float*)(ws + WS_SSQ1); P.rope = (float*)(ws + WS_ROPE);
    P.tabLP = (float2*)(ws + WS_TABLP); P.tabLS = (float2*)(ws + WS_TABLS); P.tabN1P = (float2*)(ws + WS_TABN1P); P.tabN1S = (float2*)(ws + WS_TABN1S);

    for (int u = tid; u < (LDS_BYTES - LDSCTL_OFF) / 4; u += NWAVES * 64) ((LAS unsigned*)(lds + LDSCTL_OFF))[u] = 0u;
    __syncthreads();
    XcdBarrier bar; bar.bar = (unsigned*)(ctl + CW_BAR); bar.x = 0; bar.st = nullptr;
    if (MK_N_LAUNCHES == 1) bar = xcd_barrier_post((unsigned*)(ctl + CW_BAR), MISC + 8);
    const int lo = args.ph_lo, hi = args.ph_hi;
#define IN(k) (lo <= (k) && (k) < hi)
#define SEAM(k) do { if (IN(k) && IN((k) + 1)) xcd_barrier(bar); } while (0)
    const int gw = vcu * NWAVES + wave, NGW = G * NWAVES;

    if (IN(0)) { p0_prologue(P, lds, vcu, G, tid, lane, wave); SEAM(0); }
    if (IN(1)) {
        pg8::Gemm g{P.XN, P.WinT, R, INW, DM}; pg8::StaticOrder S; S.init(R, INW, G, bx);
        EpiIn E{P.Q, P.K, P.V, P.U, P.Gt, P.bgate, P.rope};
        pg8::gemm_phase<EpiIn, pg8::StaticOrder, true, true>(lds, g, S, E);
        SEAM(1);
    }
    if (IN(2)) {
        attn_mfma(P, lds, vcu, G, tid, lane, wave);
        fft1_scalar<N1P, N2P>(P.U, P.Y, P.tabN1P, 0, NBP, vcu, G, tid);
        fft1_scalar<N1S, N2S>(P.U, P.Y, P.tabN1S, NBP, NBS, vcu, G, tid);
        SEAM(2);
    }
    if (IN(3)) {
        fft2_scalar<N1P, N2P>(P.Y, P.AB, P.tabLP, LP, 0, NBP, lds, vcu, G, tid);
        fft2_scalar<N1S, N2S>(P.Y, P.AB, P.tabLS, LS, NBP, NBS, lds, vcu, G, tid);
        SEAM(3);
    }
    if (IN(4)) {
        pg8::Gemm g{P.A, P.WaoT, R, DM, 512}; pg8::StaticOrder S; S.init(R, DM, G, bx);
        EpiAO E{P.Gt, P.out};
        pg8::gemm_phase<EpiAO, pg8::StaticOrder, true, true>(lds, g, S, E);
        SEAM(4);
    }
    if (IN(5)) {
        pg8::Gemm g{P.AB, P.WfT, R, DM, DM}; pg8::StaticOrder S; S.init(R, DM, G, bx);
        EpiF E{P.Gt, P.out, P.MG};
        pg8::gemm_phase<EpiF, pg8::StaticOrder, true, true>(lds, g, S, E);
        SEAM(5);
    }
    if (IN(6)) {
        pg8::Gemm g{P.MG, P.WoutT, R, DM, DM}; pg8::StaticOrder S; S.init(R, DM, G, bx);
        EpiOut E{P.xp, P.xs, P.out, P.H1B, P.ssq1};
        pg8::gemm_phase<EpiOut, pg8::StaticOrder, true, true>(lds, g, S, E);
        SEAM(6);
    }
    if (IN(7)) {
        pg8::Gemm g{P.H1B, P.WupT, R, FFD, DM}; pg8::StaticOrder S; S.init(R, FFD, G, bx);
        EpiUp E{P.ssq1, P.TT};
        pg8::gemm_phase<EpiUp, pg8::StaticOrder, true, true>(lds, g, S, E);
        SEAM(7);
    }
    if (IN(8)) {
        pg8::Gemm g{P.TT, P.WdnT, R, DM, FFD}; pg8::StaticOrder S; S.init(R, DM, G, bx);
        EpiDown E{P.out};
        pg8::gemm_phase<EpiDown, pg8::StaticOrder, true, true>(lds, g, S, E);
        SEAM(8);
    }
    if (IN(9)) {
        for (int r = gw; r < R; r += NGW) {
            GAS f32x4* h4 = (GAS f32x4*)(P.out + (size_t)r * DM) + lane; const GAS f32x4* g4 = (const GAS f32x4*)P.gfin + lane;
            f32x4 v[4]; float s = 0.f;
#pragma unroll
            for (int j = 0; j < 4; ++j) { v[j] = h4[64 * j]; s += (v[j].x * v[j].x + v[j].y * v[j].y) + (v[j].z * v[j].z + v[j].w * v[j].w); }
            const float rinv = 1.0f / sqrtf(wave_sum(s) * (1.0f / DM) + RMS_EPS);
#pragma unroll
            for (int j = 0; j < 4; ++j) h4[64 * j] = v[j] * rinv * g4[64 * j];
        }
    }
#undef IN
#undef SEAM
}

extern "C" void kernel_launch(void* const* d_in, const int* in_sizes, int n_in, void* d_out, int out_size, void* d_ws, size_t ws_size, hipStream_t stream) {
    static int grid = 0;
    if (grid == 0) {
        if (n_in != 14 || in_sizes[0] != RP * DM || in_sizes[1] != RS * DM || out_size != R * DM || ws_size < WS_END) {
            fprintf(stderr, "kernel_launch: unexpected shapes: n_in %d in0 %d in1 %d out %d ws %zu (need >= %zu); nothing launched\n", n_in, n_in > 0 ? in_sizes[0] : -1, n_in > 1 ? in_sizes[1] : -1, out_size, ws_size, (size_t)WS_END);
            grid = -1; return; }
        int dev = 0, cus = 0;
        if (hipGetDevice(&dev) != hipSuccess || hipDeviceGetAttribute(&cus, hipDeviceAttributeMultiprocessorCount, dev) != hipSuccess) { grid = -1; return; }
        if (hipFuncSetAttribute((const void*)mk_fwd, hipFuncAttributeMaxDynamicSharedMemorySize, LDS_BYTES) != hipSuccess) { fprintf(stderr, "kernel_launch: hipFuncSetAttribute failed\n"); grid = -1; return; }
        int per_cu = 0;
        if (hipOccupancyMaxActiveBlocksPerMultiprocessor(&per_cu, (const void*)mk_fwd, NWAVES * 64, LDS_BYTES) != hipSuccess || per_cu < 1)
            fprintf(stderr, "kernel_launch: note: occupancy query reports %d workgroups per CU\n", per_cu);
        (void)hipGetLastError();
        grid = cus;
    }
    if (grid < 0) return;
    if (hipMemsetAsync((char*)d_ws + WS_CTL, 0, CTL_ZERO_BYTES, stream) != hipSuccess) { fprintf(stderr, "kernel_launch: memset failed\n"); return; }
    Args a{};
    for (int i = 0; i < 14; ++i) a.in[i] = (const float*)d_in[i];
    a.out = (float*)d_out; a.ws = (unsigned char*)d_ws;
    if (MK_N_LAUNCHES == 1) { a.ph_lo = 0; a.ph_hi = N_PHASES; hipLaunchKernelGGL(mk_fwd, dim3(grid), dim3(NWAVES * 64), LDS_BYTES, stream, a); }
    else for (int p = 0; p < N_PHASES; ++p) { a.ph_lo = p; a.ph_hi = p + 1; hipLaunchKernelGGL(mk_fwd, dim3(grid), dim3(NWAVES * 64), LDS_BYTES, stream, a); }
    const hipError_t le = hipPeekAtLastError();
    if (le != hipSuccess) fprintf(stderr, "kernel_launch: launch failed: %s\n", hipGetErrorName(le));
}
```

```cpp
#include <hip/hip_runtime.h>
#include <cstdio>
#include <cstdint>
#include <cmath>
namespace pg8 {
#define PG8_LAS __attribute__((address_space(3)))
typedef unsigned short bf16_t;
typedef short bf16x8 __attribute__((ext_vector_type(8)));
typedef float f32x4 __attribute__((ext_vector_type(4)));
typedef unsigned u32x4 __attribute__((ext_vector_type(4)));
constexpr int BM = 256, BK = 64, HALF = 128, HTB = HALF * BK * 2  , STAGE_BYTES = 8 * HTB, NXCD = 8, WGM = 8;

__host__ __device__ __forceinline__ int lds_byte(int r, int c) { const int st = (r >> 4) * 2 + (c >> 5), rr = r & 15, cc = c & 31, ob = rr * 64 + cc * 2; return st * 1024 + (ob ^ (((ob >> 9) & 1) << 5)); }
__host__ __device__ __forceinline__ void stage_rc(int b, int& R, int& C) { const int st = b / 1024, sb = b % 1024, swz = sb ^ (((sb >> 9) & 1) << 5); R = (st >> 1) * 16 + swz / 64; C = (st & 1) * 32 + (swz % 64) / 2; }
__host__ __device__ __forceinline__ int perm32(int rho) { const int n = rho >> 4, i = rho & 15; return 8 * (i >> 2) + 4 * n + (i & 3); }

struct Unit { int pm, pn; };
struct Gemm { const bf16_t* A; const bf16_t* Bt; int M, N, K; };

struct StaticOrder {
    int nM, nN, nwg, G, c;
    __host__ __device__ void init(int M, int N, int G_, int c_) { nM = M / BM; nN = N / BM; nwg = nM * nN; G = G_; c = c_; }
    __host__ __device__ bool next(int i, Unit& u) const {
        const long L = (long)i * G + c; if (L >= nwg) return false;
        int wgid = (int)L; { const int q = nwg / NXCD, r = nwg % NXCD, xcd = wgid % NXCD, off = wgid / NXCD; wgid = (xcd < r ? xcd * (q + 1) : r * (q + 1) + (xcd - r) * q) + off; }
        const int nig = WGM * nN, gid = wgid / nig, fm = gid * WGM, gsz = (nM - fm) < WGM ? (nM - fm) : WGM;
        u.pm = fm + ((wgid % nig) % gsz); u.pn = (wgid % nig) / gsz; return true;
    }
    __device__ __forceinline__ void a_ready(const Unit&) const {}
    __device__ __forceinline__ void done(const Unit&) const {}
};

__device__ __forceinline__ unsigned cvt_pk_bf16(float lo, float hi) { unsigned r; asm volatile("v_cvt_pk_bf16_f32 %0, %1, %2" : "=v"(r) : "v"(lo), "v"(hi)); return r; }
typedef float f32x2 __attribute__((ext_vector_type(2)));
template <class Epi, class Sched, bool ALIGN_EPI = false, bool SP2 = false>
__device__ __forceinline__ void gemm_phase(PG8_LAS unsigned char* lds, const Gemm g, const Sched& S, const Epi& E) {
    const int tid = threadIdx.x, wid = __builtin_amdgcn_readfirstlane(tid >> 6), lane = tid & 63, wr = wid >> 2, wc = wid & 3, fr = lane & 15, fq = lane >> 4;
    const int K = g.K, nt = K / BK;
    unsigned voffA[2], voffB[2];
#pragma unroll
    for (int i = 0; i < 2; ++i) { int R, C; stage_rc(tid * 16 + i * 8192, R, C); const int Rb = Epi::PERM ? ((R & ~31) + perm32(R & 31)) : R;
        voffA[i] = (unsigned)(R * K + C) * 2u; voffB[i] = (unsigned)(Rb * K + C) * 2u; }
    const size_t kstep = (size_t)(BK * 2);
    const size_t hstep = (size_t)HALF * K * 2;
    const size_t tstep = 2 * hstep;
    const unsigned ldsw = (unsigned)wid * 1024u;
    const int aoff = lds_byte(wr * 64 + fr, fq * 8), boff = lds_byte(wc * 32 + fr, fq * 8);
#define PG8_SA(b, h) (((b) * 2 + (h)) * HTB)
#define PG8_SB(b, h) ((4 + (b) * 2 + (h)) * HTB)
#define PG8_STAGE(bufoff, gbase, voff) do { _Pragma("unroll") for (int _i = 0; _i < 2; ++_i) \
        __builtin_amdgcn_global_load_lds((const unsigned*)((const char*)(gbase) + (voff)[_i]), (PG8_LAS unsigned*)(lds + (bufoff) + ldsw + _i * 8192), 16, 0, 0); } while (0)
#define PG8_LDA(dst, b, h) do { _Pragma("unroll") for (int m = 0; m < 4; ++m) _Pragma("unroll") for (int k = 0; k < 2; ++k) dst[m][k] = *(const PG8_LAS bf16x8*)(lds + PG8_SA(b, h) + aoff + m * 2048 + k * 1024); } while (0)
#define PG8_LDB(dst, b, h) do { _Pragma("unroll") for (int n = 0; n < 2; ++n) _Pragma("unroll") for (int k = 0; k < 2; ++k) dst[n][k] = *(const PG8_LAS bf16x8*)(lds + PG8_SB(b, h) + boff + n * 2048 + k * 1024); } while (0)
#define PG8_MMA(ai, bj, At, Bt) do { __builtin_amdgcn_s_setprio(1); _Pragma("unroll") for (int m = 0; m < 4; ++m) _Pragma("unroll") for (int n = 0; n < 2; ++n) _Pragma("unroll") for (int k = 0; k < 2; ++k) \
        acc[ai][bj][m][n] = __builtin_amdgcn_mfma_f32_16x16x32_bf16(Bt[n][k], At[m][k], acc[ai][bj][m][n], 0, 0, 0); __builtin_amdgcn_s_setprio(0); } while (0)
#define PG8_WAIT_V(n) asm volatile("s_waitcnt vmcnt(" #n ")" ::: "memory")
#define PG8_WAIT_L(n) asm volatile("s_waitcnt lgkmcnt(" #n ")" ::: "memory")
#define PG8_BAR __builtin_amdgcn_s_barrier()
#define PG8_SCHED __builtin_amdgcn_sched_barrier(0)
    Unit cur, nxt; int ui = 0;
    if (!S.next(0, cur)) return;
    f32x4 acc[2][2][4][2];
#pragma unroll
    for (int a = 0; a < 2; ++a)
#pragma unroll
        for (int b = 0; b < 2; ++b)
#pragma unroll
            for (int m = 0; m < 4; ++m)
#pragma unroll
                for (int n = 0; n < 2; ++n) acc[a][b][m][n] = (f32x4){0.f, 0.f, 0.f, 0.f};
    bf16x8 At[4][2], B0[2][2], B1[2][2];
    const char* cA = (const char*)g.A + (size_t)cur.pm * tstep; const char* cB = (const char*)g.Bt + (size_t)cur.pn * tstep;
    S.a_ready(cur);
    if constexpr (SP2) {
        PG8_STAGE(PG8_SB(0, 0), cB, voffB); PG8_STAGE(PG8_SB(0, 1), cB + hstep, voffB); PG8_STAGE(PG8_SA(0, 0), cA, voffA); PG8_STAGE(PG8_SA(0, 1), cA + hstep, voffA);
        if (wr == 1) PG8_BAR;
        PG8_WAIT_V(2); PG8_BAR;
        PG8_STAGE(PG8_SB(1, 0), cB + kstep, voffB); PG8_STAGE(PG8_SA(1, 0), cA + kstep, voffA); PG8_STAGE(PG8_SB(1, 1), cB + hstep + kstep, voffB);
        PG8_WAIT_V(6); PG8_BAR;
    } else {
        PG8_STAGE(PG8_SB(0, 0), cB, voffB); PG8_STAGE(PG8_SA(0, 0), cA, voffA); PG8_STAGE(PG8_SB(0, 1), cB + hstep, voffB); PG8_STAGE(PG8_SA(0, 1), cA + hstep, voffA);
        if (wr == 1) PG8_BAR;
        PG8_WAIT_V(4); PG8_BAR;
        PG8_STAGE(PG8_SB(1, 0), cB + kstep, voffB); PG8_STAGE(PG8_SA(1, 0), cA + kstep, voffA); PG8_STAGE(PG8_SB(1, 1), cB + hstep + kstep, voffB);
        PG8_WAIT_V(6); PG8_BAR;
    }
    for (;;) {
        const bool has_next = S.next(ui + 1, nxt);
        const char* nA = has_next ? (const char*)g.A + (size_t)nxt.pm * tstep : cA; const char* nB = has_next ? (const char*)g.Bt + (size_t)nxt.pn * tstep : cB;
        for (int t = 0; t < nt; t += 2) {
            const bool last = (t == nt - 2);
            const char* a1 = cA + (size_t)(t + 1) * kstep;
            const char* a2 = last ? nA : cA + (size_t)(t + 2) * kstep; const char* b2 = last ? nB : cB + (size_t)(t + 2) * kstep;
            const char* a3 = a2 + kstep; const char* b3 = b2 + kstep;
            if (last && has_next) S.a_ready(nxt);
            if constexpr (SP2) {
            PG8_LDB(B0, 0, 0); PG8_LDB(B1, 0, 1); PG8_SCHED; PG8_LDA(At, 0, 0); PG8_STAGE(PG8_SA(1, 1), a1 + hstep, voffA);
            PG8_WAIT_V(8); PG8_WAIT_L(0); PG8_BAR; PG8_MMA(0, 0, At, B0); PG8_MMA(0, 1, At, B1); PG8_BAR; PG8_SCHED;
            PG8_LDA(At, 0, 1); PG8_STAGE(PG8_SB(0, 0), b2, voffB); PG8_STAGE(PG8_SB(0, 1), b2 + hstep, voffB); PG8_STAGE(PG8_SA(0, 0), a2, voffA);
            PG8_WAIT_V(8); PG8_WAIT_L(0); PG8_BAR; PG8_MMA(1, 0, At, B0); PG8_MMA(1, 1, At, B1); PG8_BAR; PG8_SCHED;
            PG8_LDB(B0, 1, 0); PG8_LDB(B1, 1, 1); PG8_SCHED; PG8_LDA(At, 1, 0); PG8_STAGE(PG8_SA(0, 1), a2 + hstep, voffA);
            PG8_WAIT_V(8); PG8_WAIT_L(0); PG8_BAR; PG8_MMA(0, 0, At, B0); PG8_MMA(0, 1, At, B1); PG8_BAR; PG8_SCHED;
            PG8_LDA(At, 1, 1); PG8_STAGE(PG8_SB(1, 0), b3, voffB); PG8_STAGE(PG8_SB(1, 1), b3 + hstep, voffB); PG8_STAGE(PG8_SA(1, 0), a3, voffA);
            PG8_WAIT_V(8); PG8_WAIT_L(0); PG8_BAR; PG8_MMA(1, 0, At, B0); PG8_MMA(1, 1, At, B1); PG8_BAR; PG8_SCHED;
            } else {
            PG8_LDB(B0, 0, 0); PG8_SCHED; PG8_LDA(At, 0, 0); PG8_STAGE(PG8_SA(1, 1), a1 + hstep, voffA);
            PG8_WAIT_L(8); PG8_BAR; PG8_WAIT_L(0); PG8_MMA(0, 0, At, B0); PG8_BAR; PG8_SCHED;
            PG8_LDB(B1, 0, 1); PG8_STAGE(PG8_SB(0, 0), b2, voffB);
            PG8_BAR; PG8_WAIT_L(0); PG8_MMA(0, 1, At, B1); PG8_BAR;
            PG8_LDA(At, 0, 1); PG8_STAGE(PG8_SA(0, 0), a2, voffA);
            PG8_BAR; PG8_WAIT_L(0); PG8_MMA(1, 0, At, B0); PG8_BAR; PG8_SCHED;
            PG8_STAGE(PG8_SB(0, 1), b2 + hstep, voffB);
            PG8_WAIT_V(6); PG8_BAR; PG8_MMA(1, 1, At, B1); PG8_BAR;
            PG8_LDB(B0, 1, 0); PG8_SCHED; PG8_LDA(At, 1, 0); PG8_STAGE(PG8_SA(0, 1), a2 + hstep, voffA);
            PG8_WAIT_L(8); PG8_BAR; PG8_WAIT_L(0); PG8_MMA(0, 0, At, B0); PG8_BAR; PG8_SCHED;
            PG8_LDB(B1, 1, 1); PG8_STAGE(PG8_SB(1, 0), b3, voffB);
            PG8_BAR; PG8_WAIT_L(0); PG8_MMA(0, 1, At, B1); PG8_BAR;
            PG8_LDA(At, 1, 1); PG8_STAGE(PG8_SA(1, 0), a3, voffA);
            PG8_BAR; PG8_WAIT_L(0); PG8_MMA(1, 0, At, B0); PG8_BAR; PG8_SCHED;
            PG8_STAGE(PG8_SB(1, 1), b3 + hstep, voffB);
            PG8_WAIT_V(6); PG8_BAR; PG8_MMA(1, 1, At, B1); PG8_BAR;
            }
        }
        if constexpr (ALIGN_EPI) { if (wr == 0) PG8_BAR; }
        if constexpr (!Epi::AFTER_DRAIN) { E(acc, cur, wr, wc, fr, fq); S.done(cur); }
        if (!has_next) break;
#pragma unroll
        for (int a = 0; a < 2; ++a)
#pragma unroll
            for (int b = 0; b < 2; ++b)
#pragma unroll
                for (int m = 0; m < 4; ++m)
#pragma unroll
                    for (int n = 0; n < 2; ++n) acc[a][b][m][n] = (f32x4){0.f, 0.f, 0.f, 0.f};
        cur = nxt; cA = nA; cB = nB; ++ui;
        if constexpr (ALIGN_EPI) { if (wr == 1) PG8_BAR; }
    }
    PG8_WAIT_V(0);
    if constexpr (!ALIGN_EPI) { if (wr == 0) PG8_BAR; }
    PG8_BAR;
    if constexpr (Epi::AFTER_DRAIN) { E.fused(acc, cur, wr, wc, fr, fq, lds, wid, lane); S.done(cur); }
#undef PG8_SA
#undef PG8_SB
#undef PG8_STAGE
#undef PG8_LDA
#undef PG8_LDB
#undef PG8_MMA
#undef PG8_WAIT_V
#undef PG8_WAIT_L
#undef PG8_BAR
#undef PG8_SCHED
}
}

#define GAS __attribute__((address_space(1)))
#define LAS __attribute__((address_space(3)))
typedef unsigned short bf16;
typedef unsigned v4u __attribute__((ext_vector_type(4)));
typedef float f32x4 __attribute__((ext_vector_type(4)));
typedef short bf16x8 __attribute__((ext_vector_type(8)));
typedef GAS unsigned gu32;
typedef GAS unsigned long long gu64;
#define RLX_AGENT __ATOMIC_RELAXED, __HIP_MEMORY_SCOPE_AGENT
#define LDS_WAIT() asm volatile("s_waitcnt lgkmcnt(0)" ::: "memory")
#define VM_WAIT() asm volatile("s_waitcnt vmcnt(0)" ::: "memory")
__device__ __forceinline__ unsigned long long rt() { return __builtin_amdgcn_s_memrealtime(); }
__device__ __forceinline__ unsigned f2bf(float f) { unsigned u = __builtin_bit_cast(unsigned, f); return (u + 0x7fffu + ((u >> 16) & 1u)) >> 16; }
__device__ __forceinline__ unsigned pk2(float lo, float hi) { return f2bf(lo) | (f2bf(hi) << 16); }
#define XB_TMO      128
#define XB_XCNT(j)  (256  + 64 * (j))
#define XB_XSUB(j)  (1280 + 64 * (j))
#define XB_XGEN(j)  (2304 + 64 * (j))
#define XB_TOP      3328
#define XB_TOPGEN   3392
#define XCD_BAR_WORDS 3456
#define XB_SPIN_CAP (1u << 18)

__device__ __forceinline__ unsigned xb_ld(unsigned* p)              { return __hip_atomic_load(p, __ATOMIC_RELAXED, __HIP_MEMORY_SCOPE_AGENT); }
__device__ __forceinline__ unsigned xb_add(unsigned* p, unsigned v) { return __hip_atomic_fetch_add(p, v, __ATOMIC_RELAXED, __HIP_MEMORY_SCOPE_AGENT); }
__device__ __forceinline__ unsigned xb_xcc_id() { return (unsigned)__builtin_amdgcn_s_getreg((3 << 11) | 20) & 0xFu; }
#define XB_SPIN(cond, bar) do { unsigned _sp = 0; while (cond) { __builtin_amdgcn_s_sleep(1); \
    if ((++_sp & 255u) == 0u) { if (xb_ld(&(bar)[XB_TMO])) break; if (_sp > XB_SPIN_CAP) { atomicAdd(&(bar)[XB_TMO], 1u); break; } } } } while (0)

struct XcdBarrier {
    unsigned* bar; unsigned x;
    volatile LAS unsigned* st;
};

__device__ __forceinline__ XcdBarrier xcd_barrier_post(unsigned* bar, volatile LAS unsigned* st) {
    XcdBarrier b; b.bar = bar; b.x = xb_xcc_id(); b.st = st;
    if (threadIdx.x == 0) (void)xb_add(&bar[XB_XCNT(b.x)], 1u);
    return b;
}
__device__ __forceinline__ void xcd_barrier_complete(unsigned* bar, unsigned x, unsigned& nloc, unsigned& nx) {
    const unsigned G = gridDim.x * gridDim.y * gridDim.z;
    unsigned sum, cnt, mine, sp = 0u;
    for (;;) {
        sum = 0u; cnt = 0u; mine = 0u;
#pragma unroll
        for (unsigned j = 0; j < 16; ++j) { const unsigned c = xb_ld(&bar[XB_XCNT(j)]); sum += c; cnt += (c > 0u) ? 1u : 0u; mine = (j == x) ? c : mine; }
        if (sum == G) break;
        __builtin_amdgcn_s_sleep(1);
        if ((++sp & 255u) == 0u) { if (xb_ld(&bar[XB_TMO])) break; if (sp > XB_SPIN_CAP) { atomicAdd(&bar[XB_TMO], 1u); break; } }
    }
    nloc = mine > 0u ? mine : 1u; nx = cnt > 0u ? cnt : 1u;
}

__device__ __forceinline__ void xcd_barrier(const XcdBarrier& b) {
    asm volatile("s_waitcnt vmcnt(0)" ::: "memory");
    __syncthreads();
    if (threadIdx.x == 0) {
        unsigned* bar = b.bar;
        __builtin_amdgcn_s_waitcnt(0);
        unsigned nloc = b.st[0], nx = b.st[1];
        if (nloc == 0u) { xcd_barrier_complete(bar, b.x, nloc, nx); b.st[0] = nloc; b.st[1] = nx; }
        const unsigned old = xb_add(&bar[XB_XSUB(b.x)], 1u);
        const unsigned gen = old / nloc;
        if (old + 1u == (gen + 1u) * nloc) {
            __builtin_amdgcn_fence(__ATOMIC_RELEASE, "agent");
            asm volatile("s_waitcnt vmcnt(0)" ::: "memory");
            const unsigned og = xb_add(&bar[XB_TOP], 1u);
            const unsigned tg = og / nx;
            if (og + 1u == (tg + 1u) * nx) xb_add(&bar[XB_TOPGEN], 1u);
            else XB_SPIN(xb_ld(&bar[XB_TOPGEN]) == tg, bar);
            __builtin_amdgcn_fence(__ATOMIC_ACQUIRE, "agent");
            xb_add(&bar[XB_XGEN(b.x)], 1u);
            asm volatile("s_waitcnt vmcnt(0)" ::: "memory");
        } else {
            XB_SPIN(xb_ld(&bar[XB_XGEN(b.x)]) == gen, bar);
            __builtin_amdgcn_fence(__ATOMIC_ACQUIRE, "agent");
            asm volatile("s_waitcnt vmcnt(0)" ::: "memory");
        }
    }
    __syncthreads();
}


constexpr int DM = 1024, FFD = 4096, INW = 3328;
constexpr int SEQP = 2048, SEQS = 8192, NBP = 16, NBS = 2;
constexpr int RP = NBP * SEQP, RS = NBS * SEQS, R = RP + RS;
constexpr int NMETA = 16, LP = SEQP + NMETA, LS = SEQS + NMETA;
constexpr int N1P = 43, N1S = 171, N2 = 48;
constexpr int UROWS = NBP * LP + NBS * LS;
constexpr float RMS_EPS = 1e-6f, LOG2E = 1.4426950408889634f, QSCALE = 0.125f * 1.4426950408889634f;
constexpr int WINDOW = 128;
#ifndef MK_N_LAUNCHES
#define MK_N_LAUNCHES 1
#endif
constexpr int N_PHASES = 10;

constexpr size_t MiB = 1u << 20;
constexpr size_t WS_CTL = 0, CTL_ZERO_BYTES = 1 * MiB;
constexpr size_t WS_WIN = 2 * MiB, WS_WAO = 9 * MiB, WS_WF = 10 * MiB, WS_WOUT = 12 * MiB, WS_WUP = 14 * MiB, WS_WDN = 22 * MiB;
constexpr size_t WS_SSQ1 = 2 * MiB;
constexpr size_t WS_ROPE = 30 * MiB;
constexpr size_t WS_D1P = 393 * MiB, WS_D1S = WS_D1P + 64 * 1024, WS_D2P = 394 * MiB, WS_D2S = 395 * MiB;
constexpr size_t WS_KMETA = 31 * MiB, WS_VMETA = 31 * MiB + 4096;
constexpr size_t WS_G = 32 * MiB, WS_Q = 224 * MiB, WS_K = 272 * MiB, WS_V = 284 * MiB, WS_U = 296 * MiB, WS_A = 345 * MiB;
constexpr size_t WS_MERGED = 224 * MiB;
constexpr size_t WS_TT = 32 * MiB;
constexpr size_t WS_H = 416 * MiB;
constexpr size_t WS_END = 512 * MiB;
static_assert(WS_U + (size_t)UROWS * 512 * 2 <= WS_A && WS_A + (size_t)R * 512 * 2 <= WS_H && WS_TT + (size_t)R * FFD * 2 <= WS_H && WS_H + (size_t)R * DM * 2 <= WS_END, "d_ws map");
static_assert(WS_WIN + (size_t)INW * DM * 2 <= WS_WAO && WS_SSQ1 + (size_t)R * 16 * 4 <= WS_WAO, "d_ws map (weights)");
constexpr int CW_BAR = 4096;

constexpr int RING_BYTES = 131072, LDSCTL_OFF = RING_BYTES, MISC_OFF = LDSCTL_OFF + 320, TAB128_OFF = LDSCTL_OFF + 1024, LDS_BYTES = 147456;
constexpr int NWAVES = 8;

__device__ __forceinline__ float bf2f(unsigned short b) { return __builtin_bit_cast(float, (unsigned)b << 16); }
__device__ __forceinline__ float bflo(unsigned u) { return __builtin_bit_cast(float, u << 16); }
__device__ __forceinline__ float bfhi(unsigned u) { return __builtin_bit_cast(float, u & 0xffff0000u); }
__device__ __forceinline__ float wave_sum(float v) {
#pragma unroll
    for (int o = 1; o < 64; o <<= 1) v += __shfl_xor(v, o);
    return v;
}
__device__ __forceinline__ void row_decode(int r, int& seq, int& s, int& S) {
    if (r < RP) { seq = r >> 11; s = r & (SEQP - 1); S = SEQP; } else { const int q = r - RP; seq = NBP + (q >> 13); s = q & (SEQS - 1); S = SEQS; }
}
__device__ __forceinline__ int useq_base(int seq) { return seq < NBP ? seq * LP : NBP * LP + (seq - NBP) * LS; }
__device__ __forceinline__ int rseq_base(int seq) { return seq < NBP ? seq * SEQP : RP + (seq - NBP) * SEQS; }
__device__ __forceinline__ float sigmoidf_fast(float x) { return __builtin_amdgcn_rcpf(1.0f + __builtin_amdgcn_exp2f(-x * LOG2E)); }

typedef pg8::u32x4 u32x4; using pg8::Unit; typedef pg8::bf16_t bf16_t; using pg8::cvt_pk_bf16;
__device__ __forceinline__ u32x4 pack8(const f32x4 a, const f32x4 b) { u32x4 w; w.x = cvt_pk_bf16(a[0], a[1]); w.y = cvt_pk_bf16(a[2], a[3]); w.z = cvt_pk_bf16(b[0], b[1]); w.w = cvt_pk_bf16(b[2], b[3]); return w; }

struct EpiIn {
    static constexpr bool PERM = true, AFTER_DRAIN = false;
    bf16_t *Q, *K, *V, *U, *G; const float* bgate; const float* rope;
    __device__ __forceinline__ void operator()(const f32x4 (&acc)[2][2][4][2], const Unit& u, int wr, int wc, int fr, int fq) const {
        const int pn = u.pn, rowt = u.pm * 256;
        int seq, s0, S; row_decode(rowt, seq, s0, S);
        const int ub = useq_base(seq) + NMETA + s0 - rowt;
        const int lane = fr + 16 * fq;
#pragma unroll
        for (int ai = 0; ai < 2; ++ai)
#pragma unroll
            for (int m = 0; m < 4; ++m) {
                const int rl = ai * 128 + wr * 64 + m * 16 + fr, row = rowt + rl;
#pragma unroll
                for (int bj = 0; bj < 2; ++bj) {
                    f32x4 v0 = acc[ai][bj][m][0], v1 = acc[ai][bj][m][1];
                    const int cc = bj * 128 + wc * 32 + 8 * fq;
                    if (pn < 3 && !(pn == 2 && bj == 1)) {
                        if ((wc & 1) == 0) {
                            f32x4 o0, o1;
#pragma unroll
                            for (int j = 0; j < 4; ++j) { o0[j] = __shfl_xor(v0[j], 16); o1[j] = __shfl_xor(v1[j], 16); }
                            if (fq < 2) {
                                const float* rp = rope + (size_t)(NMETA + s0 + rl) * 16;
                                const f32x4 c0 = *(const f32x4*)(rp), c1 = *(const f32x4*)(rp + 4), s0v = *(const f32x4*)(rp + 8), s1v = *(const f32x4*)(rp + 12);
                                const float sg = (fq == 0) ? -1.f : 1.f;
                                v0 = v0 * c0 + (o0 * s0v) * sg; v1 = v1 * c1 + (o1 * s1v) * sg;
                            }
                        }
                        if (pn < 2) { v0 = v0 * QSCALE; v1 = v1 * QSCALE; *(u32x4*)(Q + (size_t)row * 512 + pn * 256 + cc) = pack8(v0, v1); }
                        else *(u32x4*)(K + (size_t)row * 128 + cc) = pack8(v0, v1);
                    } else if (pn == 2) {
                        *(u32x4*)(V + (size_t)row * 128 + (cc - 128)) = pack8(v0, v1);
                    } else if (pn < 5) {
                        *(u32x4*)(U + (size_t)(ub + row) * 512 + (pn - 3) * 256 + cc) = pack8(v0, v1);
                    } else {
                        const int gc = (pn - 5) * 256 + cc;
                        const f32x4 b0 = *(const f32x4*)(bgate + gc), b1 = *(const f32x4*)(bgate + gc + 4);
#pragma unroll
                        for (int j = 0; j < 4; ++j) { v0[j] = sigmoidf_fast(v0[j] + b0[j]); v1[j] = sigmoidf_fast(v1[j] + b1[j]); }
                        *(u32x4*)(G + (size_t)row * 2048 + gc) = pack8(v0, v1);
                    }
                }
            }
        (void)lane;
    }
};
struct EpiAO {
    static constexpr bool PERM = true, AFTER_DRAIN = false;
    const bf16_t* G; float* tmp;
    __device__ __forceinline__ void operator()(const f32x4 (&acc)[2][2][4][2], const Unit& u, int wr, int wc, int fr, int fq) const {
#pragma unroll
        for (int ai = 0; ai < 2; ++ai)
#pragma unroll
            for (int m = 0; m < 4; ++m) {
                const int row = u.pm * 256 + ai * 128 + wr * 64 + m * 16 + fr;
#pragma unroll
                for (int bj = 0; bj < 2; ++bj) {
                    const int col = u.pn * 256 + bj * 128 + wc * 32 + 8 * fq;
                    const u32x4 g = *(const u32x4*)(G + (size_t)row * 2048 + col);
                    const f32x4 g0 = {bflo(g.x), bfhi(g.x), bflo(g.y), bfhi(g.y)}, g1 = {bflo(g.z), bfhi(g.z), bflo(g.w), bfhi(g.w)};
                    float* tp = tmp + (size_t)row * DM + col;
                    *(f32x4*)tp = acc[ai][bj][m][0] * g0; *(f32x4*)(tp + 4) = acc[ai][bj][m][1] * g1;
                }
            }
    }
};
struct EpiF {
    static constexpr bool PERM = true, AFTER_DRAIN = false;
    const bf16_t* G; const float* tmp; bf16_t* MG;
    __device__ __forceinline__ void operator()(const f32x4 (&acc)[2][2][4][2], const Unit& u, int wr, int wc, int fr, int fq) const {
#pragma unroll
        for (int ai = 0; ai < 2; ++ai)
#pragma unroll
            for (int m = 0; m < 4; ++m) {
                const int row = u.pm * 256 + ai * 128 + wr * 64 + m * 16 + fr;
#pragma unroll
                for (int bj = 0; bj < 2; ++bj) {
                    const int col = u.pn * 256 + bj * 128 + wc * 32 + 8 * fq;
                    const u32x4 g = *(const u32x4*)(G + (size_t)row * 2048 + 1024 + col);
                    const f32x4 g0 = {bflo(g.x), bfhi(g.x), bflo(g.y), bfhi(g.y)}, g1 = {bflo(g.z), bfhi(g.z), bflo(g.w), bfhi(g.w)};
                    const float* tp = tmp + (size_t)row * DM + col;
                    const f32x4 t0 = *(const f32x4*)tp, t1 = *(const f32x4*)(tp + 4);
                    *(u32x4*)(MG + (size_t)row * DM + col) = pack8(t0 + acc[ai][bj][m][0] * g0, t1 + acc[ai][bj][m][1] * g1);
                }
            }
    }
};
struct EpiOut {
    static constexpr bool PERM = true, AFTER_DRAIN = false;
    const float *xp, *xs; float* h1; bf16_t* H1B; float* ssq;
    __device__ __forceinline__ void operator()(const f32x4 (&acc)[2][2][4][2], const Unit& u, int wr, int wc, int fr, int fq) const {
#pragma unroll
        for (int ai = 0; ai < 2; ++ai)
#pragma unroll
            for (int m = 0; m < 4; ++m) {
                const int row = u.pm * 256 + ai * 128 + wr * 64 + m * 16 + fr;
                const float* xr = (row < RP) ? xp + (size_t)row * DM : xs + (size_t)(row - RP) * DM;
                float sq = 0.f;
#pragma unroll
                for (int bj = 0; bj < 2; ++bj) {
                    const int col = u.pn * 256 + bj * 128 + wc * 32 + 8 * fq;
                    const f32x4 a0 = *(const f32x4*)(xr + col) + acc[ai][bj][m][0], a1 = *(const f32x4*)(xr + col + 4) + acc[ai][bj][m][1];
                    float* hp = h1 + (size_t)row * DM + col; *(f32x4*)hp = a0; *(f32x4*)(hp + 4) = a1;
                    *(u32x4*)(H1B + (size_t)row * DM + col) = pack8(a0, a1);
                    sq += (a0[0] * a0[0] + a0[1] * a0[1]) + (a0[2] * a0[2] + a0[3] * a0[3]) + (a1[0] * a1[0] + a1[1] * a1[1]) + (a1[2] * a1[2] + a1[3] * a1[3]);
                }
                sq += __shfl_xor(sq, 16); sq += __shfl_xor(sq, 32);
                if (fq == 0) ssq[(size_t)row * 16 + u.pn * 4 + wc] = sq;
            }
    }
};
struct EpiUp {
    static constexpr bool PERM = true, AFTER_DRAIN = false;
    const float* ssq; bf16_t* TT;
    __device__ __forceinline__ void operator()(const f32x4 (&acc)[2][2][4][2], const Unit& u, int wr, int wc, int fr, int fq) const {
#pragma unroll
        for (int ai = 0; ai < 2; ++ai)
#pragma unroll
            for (int m = 0; m < 4; ++m) {
                const int row = u.pm * 256 + ai * 128 + wr * 64 + m * 16 + fr;
                const float* sp = ssq + (size_t)row * 16;
                const f32x4 p0 = *(const f32x4*)sp, p1 = *(const f32x4*)(sp + 4), p2 = *(const f32x4*)(sp + 8), p3 = *(const f32x4*)(sp + 12);
                const float tot = (((p0[0] + p0[1]) + (p0[2] + p0[3])) + ((p1[0] + p1[1]) + (p1[2] + p1[3]))) + (((p2[0] + p2[1]) + (p2[2] + p2[3])) + ((p3[0] + p3[1]) + (p3[2] + p3[3])));
                const float rinv = 1.0f / sqrtf(tot * (1.0f / DM) + RMS_EPS);
#pragma unroll
                for (int bj = 0; bj < 2; ++bj) {
                    const int col = u.pn * 256 + bj * 128 + wc * 32 + 8 * fq;
                    f32x4 a0 = acc[ai][bj][m][0] * rinv, a1 = acc[ai][bj][m][1] * rinv;
#pragma unroll
                    for (int j = 0; j < 4; ++j) { a0[j] = fmaxf(a0[j], 0.f); a0[j] *= a0[j]; a1[j] = fmaxf(a1[j], 0.f); a1[j] *= a1[j]; }
                    *(u32x4*)(TT + (size_t)row * FFD + col) = pack8(a0, a1);
                }
            }
    }
};
struct EpiDown {
    static constexpr bool PERM = true, AFTER_DRAIN = false;
    float* h;
    __device__ __forceinline__ void operator()(const f32x4 (&acc)[2][2][4][2], const Unit& u, int wr, int wc, int fr, int fq) const {
#pragma unroll
        for (int ai = 0; ai < 2; ++ai)
#pragma unroll
            for (int m = 0; m < 4; ++m) {
                const int row = u.pm * 256 + ai * 128 + wr * 64 + m * 16 + fr;
#pragma unroll
                for (int bj = 0; bj < 2; ++bj) {
                    const int col = u.pn * 256 + bj * 128 + wc * 32 + 8 * fq;
                    float* hp = h + (size_t)row * DM + col;
                    const f32x4 a0 = *(const f32x4*)hp + acc[ai][bj][m][0], a1 = *(const f32x4*)(hp + 4) + acc[ai][bj][m][1];
                    *(f32x4*)hp = a0; *(f32x4*)(hp + 4) = a1;
                }
            }
    }
};

__device__ __forceinline__ void p0_transpose_item(const float* W, int K, int N, bf16* WT, const float* gk, LAS float* scr, int item, int lane) {
    const int nblk = N / 32, kb = item / nblk, nb = item % nblk, k0 = 64 * kb, n0 = 32 * nb;
#pragma unroll 8
    for (int i = 0; i < 32; ++i) { const int kk = 2 * i + (lane >> 5); float w = W[(size_t)(k0 + kk) * N + n0 + (lane & 31)]; if (gk) w *= gk[k0 + kk]; scr[kk * 33 + (lane & 31)] = w; }
    LDS_WAIT(); asm volatile("" ::: "memory");
    const int c = lane & 7;
#pragma unroll
    for (int j = 0; j < 4; ++j) { const int n = (lane >> 3) + 8 * j; const LAS float* s = scr + (8 * c) * 33 + n;
        v4u o; o.x = pk2(s[0 * 33], s[1 * 33]); o.y = pk2(s[2 * 33], s[3 * 33]); o.z = pk2(s[4 * 33], s[5 * 33]); o.w = pk2(s[6 * 33], s[7 * 33]);
        *(GAS v4u*)(WT + (size_t)(n0 + n) * K + k0 + 8 * c) = o; }
    LDS_WAIT(); asm volatile("" ::: "memory");
}
__device__ __forceinline__ float rope_invfreq(int i) { return powf(500000.0f, -(float)i / 8.0f); }

struct Ptrs {
    const float *xp, *xs, *meta, *gmix, *win, *bgate, *sink, *wao, *wf, *wout, *gmlp, *wup, *wdn, *gfin; float* out;
    bf16 *WinT, *WaoT, *WfT, *WoutT, *WupT, *WdnT, *Gt, *Q, *K, *V, *U, *A, *MG, *TT, *XN, *AB, *H1B, *Km, *Vm, *Y;
    float *ssq1, *rope; bf16 *D1P, *D1S, *D2P, *D2S;
};

__device__ __forceinline__ void p0_prologue(const Ptrs& P, LAS unsigned char* lds, int vcu, int G, int tid, int lane, int wave) {
    LAS float* scr = (LAS float*)(lds + wave * 16384);
    LAS float* t128 = (LAS float*)(lds + TAB128_OFF);
    if (tid < 128) { t128[tid] = cospif((float)tid / 64.0f); t128[128 + tid] = sinpif((float)tid / 64.0f); }
    __syncthreads();
    const int gw = vcu * NWAVES + wave, NGW = G * NWAVES;
    constexpr int I_IN = (DM / 64) * (INW / 32), I_AO = (512 / 64) * (DM / 32), I_OUT = (DM / 64) * (DM / 32), I_UP = (DM / 64) * (FFD / 32), I_DN = (FFD / 64) * (DM / 32);
    constexpr int NT_ITEMS = I_IN + I_AO + I_OUT + I_UP + I_DN;
    for (int it = gw; it < NT_ITEMS; it += NGW) {
        int r = it;
        if (r < I_IN) { p0_transpose_item(P.win, DM, INW, P.WinT, nullptr, scr, r, lane); continue; } r -= I_IN;
        if (r < I_AO) { p0_transpose_item(P.wao, 512, DM, P.WaoT, nullptr, scr, r, lane); continue; } r -= I_AO;
        if (r < I_OUT) { p0_transpose_item(P.wout, DM, DM, P.WoutT, nullptr, scr, r, lane); continue; } r -= I_OUT;
        if (r < I_UP) { p0_transpose_item(P.wup, DM, FFD, P.WupT, P.gmlp, scr, r, lane); continue; } r -= I_UP;
        p0_transpose_item(P.wdn, FFD, DM, P.WdnT, nullptr, scr, r, lane);
    }
    for (int it = gw; it < 16 * 1024; it += NGW) {
        const int nb = it & 15, kk = it >> 4, part = kk >> 9, g = (kk >> 7) & 3, c = kk & 127, n = nb * 64 + lane;
        const float* wp = P.wf + (size_t)(g * 128) * DM + n; const LAS float* tb = t128 + part * 128;
        float a = 0.f;
#pragma unroll 16
        for (int m = 0; m < 128; ++m) a += tb[(c * m) & 127] * wp[(size_t)m * DM];
        a *= 0.08838834764831845f; if (part) a = -a;
        P.WfT[(size_t)n * DM + kk] = (bf16)f2bf(a);
    }
    for (int r = gw; r < R; r += NGW) {
        const float* xr = (r < RP) ? P.xp + (size_t)r * DM : P.xs + (size_t)(r - RP) * DM;
        const GAS f32x4* x4 = (const GAS f32x4*)xr + lane; const GAS f32x4* g4 = (const GAS f32x4*)P.gmix + lane;
        f32x4 v[4]; float s = 0.f;
#pragma unroll
        for (int j = 0; j < 4; ++j) { v[j] = x4[64 * j]; s += (v[j].x * v[j].x + v[j].y * v[j].y) + (v[j].z * v[j].z + v[j].w * v[j].w); }
        const float rinv = 1.0f / sqrtf(wave_sum(s) * (1.0f / DM) + RMS_EPS);
        GAS unsigned long long* o8 = (GAS unsigned long long*)(P.XN + (size_t)r * DM) + lane;
#pragma unroll
        for (int j = 0; j < 4; ++j) { const f32x4 gg = g4[64 * j]; const f32x4 y = v[j] * rinv * gg;
            o8[64 * j] = (unsigned long long)pk2(y.x, y.y) | ((unsigned long long)pk2(y.z, y.w) << 32); }
    }
    for (int it = gw; it < 16 * 12; it += NGW) {
        const int m = it / 12, cb = it % 12;
        { const float* mr = P.meta + (size_t)m * DM; float s = 0.f; float xv[16];
#pragma unroll
          for (int j = 0; j < 16; ++j) { xv[j] = mr[lane + 64 * j]; s += xv[j] * xv[j]; }
          const float rinv = 1.0f / sqrtf(wave_sum(s) * (1.0f / DM) + RMS_EPS);
#pragma unroll
          for (int j = 0; j < 16; ++j) scr[lane + 64 * j] = xv[j] * rinv * P.gmix[lane + 64 * j];
          LDS_WAIT(); asm volatile("" ::: "memory"); }
        const int col = 512 + cb * 64 + lane; const float* wp = P.win + col;
        float a = 0.f;
#pragma unroll 32
        for (int k = 0; k < DM; ++k) a += scr[k] * wp[(size_t)k * INW];
        LDS_WAIT(); asm volatile("" ::: "memory");
        if (cb < 2) {
            const float o = __shfl_xor(a, 8);
            if (lane < 16) { const float ang = (float)m * rope_invfreq(lane & 7); const float cs = cosf(ang), sn = sinf(ang); a = (lane < 8) ? a * cs - o * sn : a * cs + o * sn; }
            P.Km[m * 128 + cb * 64 + lane] = (bf16)f2bf(a);
        } else if (cb < 4) {
            P.Vm[m * 128 + (cb - 2) * 64 + lane] = (bf16)f2bf(a);
        } else {
            const bf16 ub = (bf16)f2bf(a);
            for (int sq = 0; sq < NBP + NBS; ++sq) P.U[(size_t)(useq_base(sq) + m) * 512 + (cb - 4) * 64 + lane] = ub;
        }
    }
    const int gt = (vcu * NWAVES + wave) * 64 + lane, NGT = G * NWAVES * 64;
    for (int e = gt; e < LS * 8; e += NGT) { const int pos = e >> 3, i = e & 7; const float ang = (float)pos * rope_invfreq(i); P.rope[pos * 16 + i] = cosf(ang); P.rope[pos * 16 + 8 + i] = sinf(ang); }
    for (int e = gt; e < 96 * 64; e += NGT) { const int m = e >> 6, l1 = e & 63; float v = 0.f;
        if (m < 2 * N1P && l1 < N1P) { const int k1 = m < N1P ? m : m - N1P; const float t = 2.0f * (float)((k1 * l1) % N1P) / (float)N1P; v = m < N1P ? cospif(t) : -sinpif(t); }
        P.D1P[e] = (bf16)f2bf(v); }
    for (int e = gt; e < 384 * 192; e += NGT) { const int m = e / 192, l1 = e % 192; float v = 0.f;
        if (m < 2 * N1S && l1 < N1S) { const int k1 = m < N1S ? m : m - N1S; const float t = 2.0f * (float)((k1 * l1) % N1S) / (float)N1S; v = m < N1S ? cospif(t) : -sinpif(t); }
        P.D1S[e] = (bf16)f2bf(v); }
    for (int e = gt; e < (N1P + N1S) * 9216; e += NGT) {
        const bool smp = e >= N1P * 9216; const int e2 = smp ? e - N1P * 9216 : e, N1 = smp ? N1S : N1P, L = smp ? LS : LP;
        const int k1 = e2 / 9216, mm = (e2 / 96) % 96, kk = e2 % 96, part = mm >= 48, k2 = mm - 48 * part, ri = kk >= 48, l2 = kk - 48 * ri;
        const int k = k1 + N1 * k2, ix = (l2 * k) % L; const float t = 2.0f * (float)ix / (float)L, c = cospif(t), s = sinpif(t);
        const float v = (part == 0 ? (ri == 0 ? c : s) : (ri == 0 ? s : -c)) / sqrtf((float)L);
        (smp ? P.D2S : P.D2P)[e2] = (bf16)f2bf(v); }
}

typedef float f32x16 __attribute__((ext_vector_type(16)));
typedef short v4i16_t __attribute__((ext_vector_type(4)));
constexpr int AT_KW = 0, AT_VW = 320 * 128, AT_KM = 2 * 320 * 128, AT_VM = AT_KM + 32 * 128;
__device__ __forceinline__ bf16x8 tr_frag(LAS unsigned char* p) {
    const v4i16_t lo = __builtin_amdgcn_ds_read_tr16_b64_v4i16((LAS v4i16_t*)p), hi = __builtin_amdgcn_ds_read_tr16_b64_v4i16((LAS v4i16_t*)(p + 8 * 128));
    return (bf16x8){lo[0], lo[1], lo[2], lo[3], hi[0], hi[1], hi[2], hi[3]};
}
__device__ __forceinline__ void attn_tile(LAS unsigned char* kt, LAS unsigned char* vt, const int mode, const bf16x8 (&qf)[4], f32x16& o0, f32x16& o1, float& m, float& l, const int lane) {
    const int r32 = lane & 31, hi = lane >> 5;
    f32x16 p;
#pragma unroll
    for (int i = 0; i < 16; ++i) p[i] = 0.f;
#pragma unroll
    for (int st = 0; st < 4; ++st) {
        const bf16x8 kf = *(const LAS bf16x8*)(kt + r32 * 128 + (((2 * st + hi) ^ (r32 & 7)) << 4));
        p = __builtin_amdgcn_mfma_f32_32x32x16_bf16(kf, qf[st], p, 0, 0, 0);
    }
    if (mode) {
#pragma unroll
        for (int i = 0; i < 16; ++i) { const int kk = (i & 3) + 8 * (i >> 2) + 4 * hi;
            const bool msk = (mode == 1) ? (kk < r32) : ((mode == 2) ? (kk > r32) : (kk >= 16));
            if (msk) p[i] = -INFINITY; }
    }
    float tm = p[0];
#pragma unroll
    for (int i = 1; i < 16; ++i) tm = fmaxf(tm, p[i]);
    tm = fmaxf(tm, __shfl_xor(tm, 32));
    const float mn = fmaxf(m, tm), a = __builtin_amdgcn_exp2f(m - mn);
    m = mn;
    float ps = 0.f;
#pragma unroll
    for (int i = 0; i < 16; ++i) { p[i] = __builtin_amdgcn_exp2f(p[i] - mn); ps += p[i]; }
    l = l * a + ps;
#pragma unroll
    for (int i = 0; i < 16; ++i) { o0[i] *= a; o1[i] *= a; }
    u32x4 w0, w1;
    w0.x = cvt_pk_bf16(p[0], p[1]); w0.y = cvt_pk_bf16(p[2], p[3]); w0.z = cvt_pk_bf16(p[4], p[5]); w0.w = cvt_pk_bf16(p[6], p[7]);
    w1.x = cvt_pk_bf16(p[8], p[9]); w1.y = cvt_pk_bf16(p[10], p[11]); w1.z = cvt_pk_bf16(p[12], p[13]); w1.w = cvt_pk_bf16(p[14], p[15]);
    const bf16x8 pb0 = __builtin_bit_cast(bf16x8, w0), pb1 = __builtin_bit_cast(bf16x8, w1);
    LAS unsigned char* vb = vt + (4 * hi + ((lane & 15) >> 2)) * 128 + (16 * ((lane >> 4) & 1) + 4 * (lane & 3)) * 2;
    o0 = __builtin_amdgcn_mfma_f32_32x32x16_bf16(tr_frag(vb), pb0, o0, 0, 0, 0);
    o1 = __builtin_amdgcn_mfma_f32_32x32x16_bf16(tr_frag(vb + 64), pb0, o1, 0, 0, 0);
    o0 = __builtin_amdgcn_mfma_f32_32x32x16_bf16(tr_frag(vb + 16 * 128), pb1, o0, 0, 0, 0);
    o1 = __builtin_amdgcn_mfma_f32_32x32x16_bf16(tr_frag(vb + 16 * 128 + 64), pb1, o1, 0, 0, 0);
}
__device__ __forceinline__ void attn_mfma(const Ptrs& P, LAS unsigned char* lds, int vcu, int G, int tid, int lane, int wave) {
    constexpr int NU_P = NBP * 2 * (SEQP / 64), NU = (R / 64) * 2;
    for (int unit = vcu; unit < NU; unit += G) {
        int seq, hk, blk, S;
        if (unit < NU_P) { seq = unit >> 6; hk = (unit >> 5) & 1; blk = unit & 31; S = SEQP; }
        else { const int u2 = unit - NU_P; seq = NBP + (u2 >> 8); hk = (u2 >> 7) & 1; blk = u2 & 127; S = SEQS; }
        const int rb = rseq_base(seq), kw0 = blk * 64 - 128;
        for (int idx = tid; idx < 320 * 8; idx += NWAVES * 64) { const int kl = idx >> 3, c = idx & 7, key = kw0 + kl;
            if (key >= 0 && key < S) { const size_t go = (size_t)(rb + key) * 128 + hk * 64 + c * 8;
                const v4u kv = *(const v4u*)(P.K + go), vv = *(const v4u*)(P.V + go);
                *(LAS v4u*)(lds + AT_KW + kl * 128 + ((c ^ (kl & 7)) << 4)) = kv; *(LAS v4u*)(lds + AT_VW + kl * 128 + (c << 4)) = vv; } }
        if (tid < 256) { const int j = tid >> 3, c = tid & 7; v4u kv = {0u, 0u, 0u, 0u}, vv = {0u, 0u, 0u, 0u};
            if (j < NMETA) { kv = *(const v4u*)(P.Km + j * 128 + hk * 64 + c * 8); vv = *(const v4u*)(P.Vm + j * 128 + hk * 64 + c * 8); }
            *(LAS v4u*)(lds + AT_KM + j * 128 + ((c ^ (j & 7)) << 4)) = kv; *(LAS v4u*)(lds + AT_VM + j * 128 + (c << 4)) = vv; }
        __syncthreads();
        {
            const int g = wave >> 1, half = wave & 1, hq = hk * 4 + g, r32 = lane & 31, hi = lane >> 5;
            const int q0 = blk * 64 + half * 32;
            const size_t qrow = (size_t)(rb + q0 + r32);
            bf16x8 qf[4];
#pragma unroll
            for (int st = 0; st < 4; ++st) qf[st] = *(const bf16x8*)(P.Q + qrow * 512 + hq * 64 + 16 * st + 8 * hi);
            float m = P.sink[hq] * LOG2E, l = hi ? 0.f : 1.f;
            f32x16 o0, o1;
#pragma unroll
            for (int i = 0; i < 16; ++i) { o0[i] = 0.f; o1[i] = 0.f; }
            attn_tile(lds + AT_KM, lds + AT_VM, 3, qf, o0, o1, m, l, lane);
            for (int j = 0; j < 9; ++j) {
                const int key0 = q0 - 128 + 32 * j;
                if (key0 < 0 || key0 >= S) continue;
                const int kl0 = key0 - kw0;
                attn_tile(lds + AT_KW + kl0 * 128, lds + AT_VW + kl0 * 128, j == 0 ? 1 : (j == 8 ? 2 : 0), qf, o0, o1, m, l, lane);
            }
            l += __shfl_xor(l, 32);
            const float il = 1.0f / l;
            bf16* op = P.A + qrow * 512 + hq * 64 + 4 * hi;
#pragma unroll
            for (int rg = 0; rg < 4; ++rg) {
                uint2 w; w.x = cvt_pk_bf16(o0[4 * rg] * il, o0[4 * rg + 1] * il); w.y = cvt_pk_bf16(o0[4 * rg + 2] * il, o0[4 * rg + 3] * il); *(uint2*)(op + 8 * rg) = w;
                uint2 x; x.x = cvt_pk_bf16(o1[4 * rg] * il, o1[4 * rg + 1] * il); x.y = cvt_pk_bf16(o1[4 * rg + 2] * il, o1[4 * rg + 3] * il); *(uint2*)(op + 32 + 8 * rg) = x;
            }
        }
        __syncthreads();
    }
}

typedef unsigned u32x2_t __attribute__((ext_vector_type(2)));
template <int KS, int NB, class BRow, class Store>
__device__ __forceinline__ void nn96_item(const bf16* Ag, const BRow& brow, const int kreal, const Store& store, LAS unsigned char* lds, int tid, int lane, int wave) {
    constexpr int KP = KS * 32, AST = (KP + 8) * 2, NT = 4 * NB * 16, BST = NT * 2 + 32, A_OFF = 0, B_OFF = 96 * AST;
    static_assert(B_OFF % 16 == 0 && B_OFF + KP * BST <= RING_BYTES, "nn96 LDS");
    for (int idx = tid; idx < 96 * KS * 4; idx += NWAVES * 64) { const int row = idx / (KS * 4), ch = idx % (KS * 4);
        *(LAS v4u*)(lds + A_OFF + row * AST + ch * 16) = *(const v4u*)(Ag + (size_t)row * KP + ch * 8); }
    for (int idx = tid; idx < KP * (NT / 8); idx += NWAVES * 64) { const int row = idx / (NT / 8), ch = idx % (NT / 8); v4u v = {0u, 0u, 0u, 0u};
        if (row < kreal) v = *(const v4u*)(brow(row) + ch * 8);
        *(LAS v4u*)(lds + B_OFF + row * BST + ch * 16) = v; }
    __syncthreads();
    const int wm = wave >> 2, wn = wave & 3, fr = lane & 15, fq = lane >> 4;
    f32x4 acc[3][NB];
#pragma unroll
    for (int mb = 0; mb < 3; ++mb)
#pragma unroll
        for (int nb = 0; nb < NB; ++nb) acc[mb][nb] = (f32x4){0.f, 0.f, 0.f, 0.f};
#pragma unroll
    for (int ks = 0; ks < KS; ++ks) {
        bf16x8 af[3];
#pragma unroll
        for (int mb = 0; mb < 3; ++mb) af[mb] = *(const LAS bf16x8*)(lds + A_OFF + (wm * 48 + mb * 16 + fr) * AST + (ks * 32 + fq * 8) * 2);
#pragma unroll
        for (int nb = 0; nb < NB; ++nb) {
            LAS unsigned char* p = lds + B_OFF + (ks * 32 + 8 * fq + (fr >> 2)) * BST + ((wn * NB + nb) * 16 + 4 * (lane & 3)) * 2;
            const v4i16_t lo = __builtin_amdgcn_ds_read_tr16_b64_v4i16((LAS v4i16_t*)p), hi = __builtin_amdgcn_ds_read_tr16_b64_v4i16((LAS v4i16_t*)(p + 4 * BST));
            const bf16x8 bfr = (bf16x8){lo[0], lo[1], lo[2], lo[3], hi[0], hi[1], hi[2], hi[3]};
#pragma unroll
            for (int mb = 0; mb < 3; ++mb) acc[mb][nb] = __builtin_amdgcn_mfma_f32_16x16x32_bf16(bfr, af[mb], acc[mb][nb], 0, 0, 0);
        }
    }
#pragma unroll
    for (int mb = 0; mb < 3; ++mb)
#pragma unroll
        for (int nb = 0; nb < NB; ++nb) store(wm * 48 + mb * 16 + fr, (wn * NB + nb) * 16 + 4 * fq, acc[mb][nb]);
    __syncthreads();
}
__device__ __forceinline__ u32x2_t pack4(const f32x4 v) { u32x2_t w; w.x = cvt_pk_bf16(v[0], v[1]); w.y = cvt_pk_bf16(v[2], v[3]); return w; }
struct BRowS1 { const bf16* base; __device__ __forceinline__ const bf16* operator()(int kk) const { return base + (size_t)kk * (N2 * 512); } };
struct StoreS1 { bf16* base; int mlim, moff; __device__ __forceinline__ void operator()(int m, int n, const f32x4 v) const { const int mg = moff + m; if (mg < mlim) *(u32x2_t*)(base + (size_t)mg * (N2 * 512) + n) = pack4(v); } };
__device__ __forceinline__ void fft_stage1(const Ptrs& P, LAS unsigned char* lds, int vcu, int G, int tid, int lane, int wave) {
    constexpr int IT_P = NBP * 48, IT_S = NBS * 192 * 4;
    for (int it = vcu; it < IT_P + IT_S; it += G) {
        if (it < IT_P) { const int seq = it / 48, nt = it % 48; const size_t ub = (size_t)useq_base(seq) * 512, yb = (size_t)useq_base(seq) * 1024;
            nn96_item<2, 8>(P.D1P, BRowS1{P.U + ub + nt * 512}, N1P, StoreS1{P.Y + yb + nt * 512, 2 * N1P, 0}, lds, tid, lane, wave); }
        else { const int i2 = it - IT_P, mc = i2 & 3, nt = (i2 >> 2) % 192, seq = NBP + (i2 >> 2) / 192; const size_t ub = (size_t)useq_base(seq) * 512, yb = (size_t)useq_base(seq) * 1024;
            nn96_item<6, 2>(P.D1S + (size_t)mc * 96 * 192, BRowS1{P.U + ub + nt * 128}, N1S, StoreS1{P.Y + yb + nt * 128, 2 * N1S, mc * 96}, lds, tid, lane, wave); }
    }
}
struct BRowS2 { const bf16* yr; const bf16* yi; __device__ __forceinline__ const bf16* operator()(int kk) const { return kk < 48 ? yr + (size_t)kk * 512 : yi + (size_t)(kk - 48) * 512; } };
struct StoreS2 { bf16* ab; int k1, N1; __device__ __forceinline__ void operator()(int mm, int n, const f32x4 v) const {
    const int part = mm >= 48, k = k1 + N1 * (mm - 48 * part); if (k >= NMETA) *(u32x2_t*)(ab + (size_t)(k - NMETA) * 1024 + part * 512 + n) = pack4(v); } };
__device__ __forceinline__ void fft_stage2(const Ptrs& P, LAS unsigned char* lds, int vcu, int G, int tid, int lane, int wave) {
    constexpr int IT_P = NBP * N1P, IT_S = NBS * N1S;
    for (int it = vcu; it < IT_P + IT_S; it += G) {
        const bool smp = it >= IT_P; const int i2 = smp ? it - IT_P : it, N1 = smp ? N1S : N1P, seq = smp ? NBP + i2 / N1S : i2 / N1P, k1 = smp ? i2 % N1S : i2 % N1P;
        const size_t yb = (size_t)useq_base(seq) * 1024;
        nn96_item<3, 8>((smp ? P.D2S : P.D2P) + (size_t)k1 * 9216, BRowS2{P.Y + yb + (size_t)(k1 * 48) * 512, P.Y + yb + (size_t)((N1 + k1) * 48) * 512}, 96,
                        StoreS2{P.AB + (size_t)rseq_base(seq) * 1024, k1, N1}, lds, tid, lane, wave);
    }
}

struct Args { const float* in[14]; float* out; unsigned char* ws; int ph_lo, ph_hi; };
__global__ void __launch_bounds__(NWAVES * 64, 2) mk_fwd(Args args) {
    extern __shared__ __attribute__((aligned(16))) unsigned char lds_raw[];
    LAS unsigned char* lds = (LAS unsigned char*)lds_raw;
    volatile LAS unsigned* MISC = (volatile LAS unsigned*)(lds + MISC_OFF);
    const int tid = threadIdx.x, lane = tid & 63, wave = __builtin_amdgcn_readfirstlane(tid >> 6);
    const int G = gridDim.x, bx = blockIdx.x, vcu = (G % 8 == 0) ? (bx % 8) * (G / 8) + bx / 8 : bx;
    unsigned char* ws = args.ws;
    gu32* ctl = (gu32*)(ws + WS_CTL);
    Ptrs P;
    P.xp = args.in[0]; P.xs = args.in[1]; P.meta = args.in[2]; P.gmix = args.in[3]; P.win = args.in[4]; P.bgate = args.in[5]; P.sink = args.in[6]; P.wao = args.in[7];
    P.wf = args.in[8]; P.wout = args.in[9]; P.gmlp = args.in[10]; P.wup = args.in[11]; P.wdn = args.in[12]; P.gfin = args.in[13]; P.out = args.out;
    P.WinT = (bf16*)(ws + WS_WIN); P.WaoT = (bf16*)(ws + WS_WAO); P.WfT = (bf16*)(ws + WS_WF); P.WoutT = (bf16*)(ws + WS_WOUT); P.WupT = (bf16*)(ws + WS_WUP); P.WdnT = (bf16*)(ws + WS_WDN);
    P.Gt = (bf16*)(ws + WS_G); P.Q = (bf16*)(ws + WS_Q); P.K = (bf16*)(ws + WS_K); P.V = (bf16*)(ws + WS_V); P.U = (bf16*)(ws + WS_U); P.A = (bf16*)(ws + WS_A);
    P.MG = (bf16*)(ws + WS_MERGED); P.TT = (bf16*)(ws + WS_TT); P.XN = (bf16*)(ws + WS_H); P.AB = (bf16*)(ws + WS_H); P.H1B = (bf16*)(ws + WS_H);
    P.Km = (bf16*)(ws + WS_KMETA); P.Vm = (bf16*)(ws + WS_VMETA); P.Y = (bf16*)args.out;
    P.ssq1 = (float*)(ws + WS_SSQ1); P.rope = (float*)(ws + WS_ROPE);
    P.D1P = (bf16*)(ws + WS_D1P); P.D1S = (bf16*)(ws + WS_D1S); P.D2P = (bf16*)(ws + WS_D2P); P.D2S = (bf16*)(ws + WS_D2S);

    for (int u = tid; u < (LDS_BYTES - LDSCTL_OFF) / 4; u += NWAVES * 64) ((LAS unsigned*)(lds + LDSCTL_OFF))[u] = 0u;
    __syncthreads();
    XcdBarrier bar; bar.bar = (unsigned*)(ctl + CW_BAR); bar.x = 0; bar.st = nullptr;
    if (MK_N_LAUNCHES == 1) bar = xcd_barrier_post((unsigned*)(ctl + CW_BAR), MISC + 8);
    const int lo = args.ph_lo, hi = args.ph_hi;
#define IN(k) (lo <= (k) && (k) < hi)
#define SEAM(k) do { if (IN(k) && IN((k) + 1)) xcd_barrier(bar); } while (0)
    const int gw = vcu * NWAVES + wave, NGW = G * NWAVES;

    if (IN(0)) { p0_prologue(P, lds, vcu, G, tid, lane, wave); SEAM(0); }
    if (IN(1)) {
        pg8::Gemm g{P.XN, P.WinT, R, INW, DM}; pg8::StaticOrder S; S.init(R, INW, G, bx);
        EpiIn E{P.Q, P.K, P.V, P.U, P.Gt, P.bgate, P.rope};
        pg8::gemm_phase<EpiIn, pg8::StaticOrder, true, true>(lds, g, S, E);
        SEAM(1);
    }
    if (IN(2)) {
        attn_mfma(P, lds, vcu, G, tid, lane, wave);
        fft_stage1(P, lds, vcu, G, tid, lane, wave);
        SEAM(2);
    }
    if (IN(3)) {
        fft_stage2(P, lds, vcu, G, tid, lane, wave);
        SEAM(3);
    }
    if (IN(4)) {
        pg8::Gemm g{P.A, P.WaoT, R, DM, 512}; pg8::StaticOrder S; S.init(R, DM, G, bx);
        EpiAO E{P.Gt, P.out};
        pg8::gemm_phase<EpiAO, pg8::StaticOrder, true, true>(lds, g, S, E);
        SEAM(4);
    }
    if (IN(5)) {
        pg8::Gemm g{P.AB, P.WfT, R, DM, DM}; pg8::StaticOrder S; S.init(R, DM, G, bx);
        EpiF E{P.Gt, P.out, P.MG};
        pg8::gemm_phase<EpiF, pg8::StaticOrder, true, true>(lds, g, S, E);
        SEAM(5);
    }
    if (IN(6)) {
        pg8::Gemm g{P.MG, P.WoutT, R, DM, DM}; pg8::StaticOrder S; S.init(R, DM, G, bx);
        EpiOut E{P.xp, P.xs, P.out, P.H1B, P.ssq1};
        pg8::gemm_phase<EpiOut, pg8::StaticOrder, true, true>(lds, g, S, E);
        SEAM(6);
    }
    if (IN(7)) {
        pg8::Gemm g{P.H1B, P.WupT, R, FFD, DM}; pg8::StaticOrder S; S.init(R, FFD, G, bx);
        EpiUp E{P.ssq1, P.TT};
        pg8::gemm_phase<EpiUp, pg8::StaticOrder, true, true>(lds, g, S, E);
        SEAM(7);
    }
    if (IN(8)) {
        pg8::Gemm g{P.TT, P.WdnT, R, DM, FFD}; pg8::StaticOrder S; S.init(R, DM, G, bx);
        EpiDown E{P.out};
        pg8::gemm_phase<EpiDown, pg8::StaticOrder, true, true>(lds, g, S, E);
        SEAM(8);
    }
    if (IN(9)) {
        for (int r = gw; r < R; r += NGW) {
            GAS f32x4* h4 = (GAS f32x4*)(P.out + (size_t)r * DM) + lane; const GAS f32x4* g4 = (const GAS f32x4*)P.gfin + lane;
            f32x4 v[4]; float s = 0.f;
#pragma unroll
            for (int j = 0; j < 4; ++j) { v[j] = h4[64 * j]; s += (v[j].x * v[j].x + v[j].y * v[j].y) + (v[j].z * v[j].z + v[j].w * v[j].w); }
            const float rinv = 1.0f / sqrtf(wave_sum(s) * (1.0f / DM) + RMS_EPS);
#pragma unroll
            for (int j = 0; j < 4; ++j) h4[64 * j] = v[j] * rinv * g4[64 * j];
        }
    }
#undef IN
#undef SEAM
}

extern "C" void kernel_launch(void* const* d_in, const int* in_sizes, int n_in, void* d_out, int out_size, void* d_ws, size_t ws_size, hipStream_t stream) {
    static int grid = 0;
    if (grid == 0) {
        if (n_in != 14 || in_sizes[0] != RP * DM || in_sizes[1] != RS * DM || out_size != R * DM || ws_size < WS_END) {
            fprintf(stderr, "kernel_launch: unexpected shapes: n_in %d in0 %d in1 %d out %d ws %zu (need >= %zu); nothing launched\n", n_in, n_in > 0 ? in_sizes[0] : -1, n_in > 1 ? in_sizes[1] : -1, out_size, ws_size, (size_t)WS_END);
            grid = -1; return; }
        int dev = 0, cus = 0;
        if (hipGetDevice(&dev) != hipSuccess || hipDeviceGetAttribute(&cus, hipDeviceAttributeMultiprocessorCount, dev) != hipSuccess) { grid = -1; return; }
        if (hipFuncSetAttribute((const void*)mk_fwd, hipFuncAttributeMaxDynamicSharedMemorySize, LDS_BYTES) != hipSuccess) { fprintf(stderr, "kernel_launch: hipFuncSetAttribute failed\n"); grid = -1; return; }
        int per_cu = 0;
        if (hipOccupancyMaxActiveBlocksPerMultiprocessor(&per_cu, (const void*)mk_fwd, NWAVES * 64, LDS_BYTES) != hipSuccess || per_cu < 1)
            fprintf(stderr, "kernel_launch: note: occupancy query reports %d workgroups per CU\n", per_cu);
        (void)hipGetLastError();
        grid = cus;
    }
    if (grid < 0) return;
    if (hipMemsetAsync((char*)d_ws + WS_CTL, 0, CTL_ZERO_BYTES, stream) != hipSuccess) { fprintf(stderr, "kernel_launch: memset failed\n"); return; }
    Args a{};
    for (int i = 0; i < 14; ++i) a.in[i] = (const float*)d_in[i];
    a.out = (float*)d_out; a.ws = (unsigned char*)d_ws;
    if (MK_N_LAUNCHES == 1) { a.ph_lo = 0; a.ph_hi = N_PHASES; hipLaunchKernelGGL(mk_fwd, dim3(grid), dim3(NWAVES * 64), LDS_BYTES, stream, a); }
    else for (int p = 0; p < N_PHASES; ++p) { a.ph_lo = p; a.ph_hi = p + 1; hipLaunchKernelGGL(mk_fwd, dim3(grid), dim3(NWAVES * 64), LDS_BYTES, stream, a); }
    const hipError_t le = hipPeekAtLastError();
    if (le != hipSuccess) fprintf(stderr, "kernel_launch: launch failed: %s\n", hipGetErrorName(le));
}
```

```cpp
#include <hip/hip_runtime.h>
#include <cstdio>
#include <cstdint>
#include <cmath>
namespace pg8 {
#define PG8_LAS __attribute__((address_space(3)))
typedef unsigned short bf16_t;
typedef short bf16x8 __attribute__((ext_vector_type(8)));
typedef float f32x4 __attribute__((ext_vector_type(4)));
typedef unsigned u32x4 __attribute__((ext_vector_type(4)));
constexpr int BM = 256, BK = 64, HALF = 128, HTB = HALF * BK * 2  , STAGE_BYTES = 8 * HTB, NXCD = 8, WGM = 8;

__host__ __device__ __forceinline__ int lds_byte(int r, int c) { const int st = (r >> 4) * 2 + (c >> 5), rr = r & 15, cc = c & 31, ob = rr * 64 + cc * 2; return st * 1024 + (ob ^ (((ob >> 9) & 1) << 5)); }
__host__ __device__ __forceinline__ void stage_rc(int b, int& R, int& C) { const int st = b / 1024, sb = b % 1024, swz = sb ^ (((sb >> 9) & 1) << 5); R = (st >> 1) * 16 + swz / 64; C = (st & 1) * 32 + (swz % 64) / 2; }
__host__ __device__ __forceinline__ int perm32(int rho) { const int n = rho >> 4, i = rho & 15; return 8 * (i >> 2) + 4 * n + (i & 3); }

struct Unit { int pm, pn; };
struct Gemm { const bf16_t* A; const bf16_t* Bt; int M, N, K, lda; };

struct StaticOrder {
    int nM, nN, nwg, G, c;
    __host__ __device__ void init(int M, int N, int G_, int c_) { nM = M / BM; nN = N / BM; nwg = nM * nN; G = G_; c = c_; }
    __host__ __device__ bool next(int i, Unit& u) const {
        const long L = (long)i * G + c; if (L >= nwg) return false;
        int wgid = (int)L; { const int q = nwg / NXCD, r = nwg % NXCD, xcd = wgid % NXCD, off = wgid / NXCD; wgid = (xcd < r ? xcd * (q + 1) : r * (q + 1) + (xcd - r) * q) + off; }
        const int nig = WGM * nN, gid = wgid / nig, fm = gid * WGM, gsz = (nM - fm) < WGM ? (nM - fm) : WGM;
        u.pm = fm + ((wgid % nig) % gsz); u.pn = (wgid % nig) / gsz; return true;
    }
    __device__ __forceinline__ void a_ready(const Unit&) const {}
    __device__ __forceinline__ void done(const Unit&) const {}
};

__device__ __forceinline__ unsigned cvt_pk_bf16(float lo, float hi) { unsigned r; asm volatile("v_cvt_pk_bf16_f32 %0, %1, %2" : "=v"(r) : "v"(lo), "v"(hi)); return r; }
typedef float f32x2 __attribute__((ext_vector_type(2)));
template <class Epi, class Sched, bool ALIGN_EPI = false, bool SP2 = false>
__device__ __forceinline__ void gemm_phase(PG8_LAS unsigned char* lds, const Gemm g, const Sched& S, const Epi& E) {
    const int tid = threadIdx.x, wid = __builtin_amdgcn_readfirstlane(tid >> 6), lane = tid & 63, wr = wid >> 2, wc = wid & 3, fr = lane & 15, fq = lane >> 4;
    const int K = g.K, nt = K / BK;
    unsigned voffA[2], voffB[2];
#pragma unroll
    for (int i = 0; i < 2; ++i) { int R, C; stage_rc(tid * 16 + i * 8192, R, C); const int Rb = Epi::PERM ? ((R & ~31) + perm32(R & 31)) : R;
        voffA[i] = (unsigned)(R * g.lda + C) * 2u; voffB[i] = (unsigned)(Rb * K + C) * 2u; }
    const size_t kstep = (size_t)(BK * 2);
    const size_t hstep = (size_t)HALF * K * 2;
    const size_t tstep = 2 * hstep;
    const size_t hstepA = (size_t)HALF * g.lda * 2, tstepA = 2 * hstepA;
    const unsigned ldsw = (unsigned)wid * 1024u;
    const int aoff = lds_byte(wr * 64 + fr, fq * 8), boff = lds_byte(wc * 32 + fr, fq * 8);
#define PG8_SA(b, h) (((b) * 2 + (h)) * HTB)
#define PG8_SB(b, h) ((4 + (b) * 2 + (h)) * HTB)
#define PG8_STAGE(bufoff, gbase, voff) do { _Pragma("unroll") for (int _i = 0; _i < 2; ++_i) \
        __builtin_amdgcn_global_load_lds((const unsigned*)((const char*)(gbase) + (voff)[_i]), (PG8_LAS unsigned*)(lds + (bufoff) + ldsw + _i * 8192), 16, 0, 0); } while (0)
#define PG8_LDA(dst, b, h) do { _Pragma("unroll") for (int m = 0; m < 4; ++m) _Pragma("unroll") for (int k = 0; k < 2; ++k) dst[m][k] = *(const PG8_LAS bf16x8*)(lds + PG8_SA(b, h) + aoff + m * 2048 + k * 1024); } while (0)
#define PG8_LDB(dst, b, h) do { _Pragma("unroll") for (int n = 0; n < 2; ++n) _Pragma("unroll") for (int k = 0; k < 2; ++k) dst[n][k] = *(const PG8_LAS bf16x8*)(lds + PG8_SB(b, h) + boff + n * 2048 + k * 1024); } while (0)
#define PG8_MMA(ai, bj, At, Bt) do { __builtin_amdgcn_s_setprio(1); _Pragma("unroll") for (int m = 0; m < 4; ++m) _Pragma("unroll") for (int n = 0; n < 2; ++n) _Pragma("unroll") for (int k = 0; k < 2; ++k) \
        acc[ai][bj][m][n] = __builtin_amdgcn_mfma_f32_16x16x32_bf16(Bt[n][k], At[m][k], acc[ai][bj][m][n], 0, 0, 0); __builtin_amdgcn_s_setprio(0); } while (0)
#define PG8_WAIT_V(n) asm volatile("s_waitcnt vmcnt(" #n ")" ::: "memory")
#define PG8_WAIT_L(n) asm volatile("s_waitcnt lgkmcnt(" #n ")" ::: "memory")
#define PG8_BAR __builtin_amdgcn_s_barrier()
#define PG8_SCHED __builtin_amdgcn_sched_barrier(0)
    Unit cur, nxt; int ui = 0;
    if (!S.next(0, cur)) return;
    f32x4 acc[2][2][4][2];
#pragma unroll
    for (int a = 0; a < 2; ++a)
#pragma unroll
        for (int b = 0; b < 2; ++b)
#pragma unroll
            for (int m = 0; m < 4; ++m)
#pragma unroll
                for (int n = 0; n < 2; ++n) acc[a][b][m][n] = (f32x4){0.f, 0.f, 0.f, 0.f};
    bf16x8 At[4][2], B0[2][2], B1[2][2];
    const char* cA = (const char*)g.A + (size_t)cur.pm * tstepA; const char* cB = (const char*)g.Bt + (size_t)cur.pn * tstep;
    S.a_ready(cur);
    if constexpr (SP2) {
        PG8_STAGE(PG8_SB(0, 0), cB, voffB); PG8_STAGE(PG8_SB(0, 1), cB + hstep, voffB); PG8_STAGE(PG8_SA(0, 0), cA, voffA); PG8_STAGE(PG8_SA(0, 1), cA + hstepA, voffA);
        if (wr == 1) PG8_BAR;
        PG8_WAIT_V(2); PG8_BAR;
        PG8_STAGE(PG8_SB(1, 0), cB + kstep, voffB); PG8_STAGE(PG8_SA(1, 0), cA + kstep, voffA); PG8_STAGE(PG8_SB(1, 1), cB + hstep + kstep, voffB);
        PG8_WAIT_V(6); PG8_BAR;
    } else {
        PG8_STAGE(PG8_SB(0, 0), cB, voffB); PG8_STAGE(PG8_SA(0, 0), cA, voffA); PG8_STAGE(PG8_SB(0, 1), cB + hstep, voffB); PG8_STAGE(PG8_SA(0, 1), cA + hstepA, voffA);
        if (wr == 1) PG8_BAR;
        PG8_WAIT_V(4); PG8_BAR;
        PG8_STAGE(PG8_SB(1, 0), cB + kstep, voffB); PG8_STAGE(PG8_SA(1, 0), cA + kstep, voffA); PG8_STAGE(PG8_SB(1, 1), cB + hstep + kstep, voffB);
        PG8_WAIT_V(6); PG8_BAR;
    }
    for (;;) {
        const bool has_next = S.next(ui + 1, nxt);
        const char* nA = has_next ? (const char*)g.A + (size_t)nxt.pm * tstepA : cA; const char* nB = has_next ? (const char*)g.Bt + (size_t)nxt.pn * tstep : cB;
        for (int t = 0; t < nt; t += 2) {
            const bool last = (t == nt - 2);
            const char* a1 = cA + (size_t)(t + 1) * kstep;
            const char* a2 = last ? nA : cA + (size_t)(t + 2) * kstep; const char* b2 = last ? nB : cB + (size_t)(t + 2) * kstep;
            const char* a3 = a2 + kstep; const char* b3 = b2 + kstep;
            if (last && has_next) S.a_ready(nxt);
            if constexpr (SP2) {
            PG8_LDB(B0, 0, 0); PG8_LDB(B1, 0, 1); PG8_SCHED; PG8_LDA(At, 0, 0); PG8_STAGE(PG8_SA(1, 1), a1 + hstepA, voffA);
            PG8_WAIT_V(8); PG8_WAIT_L(0); PG8_BAR; PG8_MMA(0, 0, At, B0); PG8_MMA(0, 1, At, B1); PG8_BAR; PG8_SCHED;
            PG8_LDA(At, 0, 1); PG8_STAGE(PG8_SB(0, 0), b2, voffB); PG8_STAGE(PG8_SB(0, 1), b2 + hstep, voffB); PG8_STAGE(PG8_SA(0, 0), a2, voffA);
            PG8_WAIT_V(8); PG8_WAIT_L(0); PG8_BAR; PG8_MMA(1, 0, At, B0); PG8_MMA(1, 1, At, B1); PG8_BAR; PG8_SCHED;
            PG8_LDB(B0, 1, 0); PG8_LDB(B1, 1, 1); PG8_SCHED; PG8_LDA(At, 1, 0); PG8_STAGE(PG8_SA(0, 1), a2 + hstepA, voffA);
            PG8_WAIT_V(8); PG8_WAIT_L(0); PG8_BAR; PG8_MMA(0, 0, At, B0); PG8_MMA(0, 1, At, B1); PG8_BAR; PG8_SCHED;
            PG8_LDA(At, 1, 1); PG8_STAGE(PG8_SB(1, 0), b3, voffB); PG8_STAGE(PG8_SB(1, 1), b3 + hstep, voffB); PG8_STAGE(PG8_SA(1, 0), a3, voffA);
            PG8_WAIT_V(8); PG8_WAIT_L(0); PG8_BAR; PG8_MMA(1, 0, At, B0); PG8_MMA(1, 1, At, B1); PG8_BAR; PG8_SCHED;
            } else {
            PG8_LDB(B0, 0, 0); PG8_SCHED; PG8_LDA(At, 0, 0); PG8_STAGE(PG8_SA(1, 1), a1 + hstepA, voffA);
            PG8_WAIT_L(8); PG8_BAR; PG8_WAIT_L(0); PG8_MMA(0, 0, At, B0); PG8_BAR; PG8_SCHED;
            PG8_LDB(B1, 0, 1); PG8_STAGE(PG8_SB(0, 0), b2, voffB);
            PG8_BAR; PG8_WAIT_L(0); PG8_MMA(0, 1, At, B1); PG8_BAR;
            PG8_LDA(At, 0, 1); PG8_STAGE(PG8_SA(0, 0), a2, voffA);
            PG8_BAR; PG8_WAIT_L(0); PG8_MMA(1, 0, At, B0); PG8_BAR; PG8_SCHED;
            PG8_STAGE(PG8_SB(0, 1), b2 + hstep, voffB);
            PG8_WAIT_V(6); PG8_BAR; PG8_MMA(1, 1, At, B1); PG8_BAR;
            PG8_LDB(B0, 1, 0); PG8_SCHED; PG8_LDA(At, 1, 0); PG8_STAGE(PG8_SA(0, 1), a2 + hstepA, voffA);
            PG8_WAIT_L(8); PG8_BAR; PG8_WAIT_L(0); PG8_MMA(0, 0, At, B0); PG8_BAR; PG8_SCHED;
            PG8_LDB(B1, 1, 1); PG8_STAGE(PG8_SB(1, 0), b3, voffB);
            PG8_BAR; PG8_WAIT_L(0); PG8_MMA(0, 1, At, B1); PG8_BAR;
            PG8_LDA(At, 1, 1); PG8_STAGE(PG8_SA(1, 0), a3, voffA);
            PG8_BAR; PG8_WAIT_L(0); PG8_MMA(1, 0, At, B0); PG8_BAR; PG8_SCHED;
            PG8_STAGE(PG8_SB(1, 1), b3 + hstep, voffB);
            PG8_WAIT_V(6); PG8_BAR; PG8_MMA(1, 1, At, B1); PG8_BAR;
            }
        }
        if constexpr (ALIGN_EPI) { if (wr == 0) PG8_BAR; }
        if constexpr (!Epi::AFTER_DRAIN) { E(acc, cur, wr, wc, fr, fq); S.done(cur); }
        if (!has_next) break;
#pragma unroll
        for (int a = 0; a < 2; ++a)
#pragma unroll
            for (int b = 0; b < 2; ++b)
#pragma unroll
                for (int m = 0; m < 4; ++m)
#pragma unroll
                    for (int n = 0; n < 2; ++n) acc[a][b][m][n] = (f32x4){0.f, 0.f, 0.f, 0.f};
        cur = nxt; cA = nA; cB = nB; ++ui;
        if constexpr (ALIGN_EPI) { if (wr == 1) PG8_BAR; }
    }
    PG8_WAIT_V(0);
    if constexpr (!ALIGN_EPI) { if (wr == 0) PG8_BAR; }
    PG8_BAR;
    if constexpr (Epi::AFTER_DRAIN) { E.fused(acc, cur, wr, wc, fr, fq, lds, wid, lane); S.done(cur); }
#undef PG8_SA
#undef PG8_SB
#undef PG8_STAGE
#undef PG8_LDA
#undef PG8_LDB
#undef PG8_MMA
#undef PG8_WAIT_V
#undef PG8_WAIT_L
#undef PG8_BAR
#undef PG8_SCHED
}
}

#define GAS __attribute__((address_space(1)))
#define LAS __attribute__((address_space(3)))
typedef unsigned short bf16;
typedef unsigned v4u __attribute__((ext_vector_type(4)));
typedef float f32x4 __attribute__((ext_vector_type(4)));
typedef short bf16x8 __attribute__((ext_vector_type(8)));
typedef GAS unsigned gu32;
typedef GAS unsigned long long gu64;
#define RLX_AGENT __ATOMIC_RELAXED, __HIP_MEMORY_SCOPE_AGENT
#define LDS_WAIT() asm volatile("s_waitcnt lgkmcnt(0)" ::: "memory")
#define VM_WAIT() asm volatile("s_waitcnt vmcnt(0)" ::: "memory")
__device__ __forceinline__ unsigned long long rt() { return __builtin_amdgcn_s_memrealtime(); }
__device__ __forceinline__ unsigned f2bf(float f) { unsigned u = __builtin_bit_cast(unsigned, f); return (u + 0x7fffu + ((u >> 16) & 1u)) >> 16; }
__device__ __forceinline__ unsigned pk2(float lo, float hi) { return f2bf(lo) | (f2bf(hi) << 16); }
#define XB_TMO      128
#define XB_XCNT(j)  (256  + 64 * (j))
#define XB_XSUB(j)  (1280 + 64 * (j))
#define XB_XGEN(j)  (2304 + 64 * (j))
#define XB_TOP      3328
#define XB_TOPGEN   3392
#define XCD_BAR_WORDS 3456
#define XB_SPIN_CAP (1u << 18)

__device__ __forceinline__ unsigned xb_ld(unsigned* p)              { return __hip_atomic_load(p, __ATOMIC_RELAXED, __HIP_MEMORY_SCOPE_AGENT); }
__device__ __forceinline__ unsigned xb_add(unsigned* p, unsigned v) { return __hip_atomic_fetch_add(p, v, __ATOMIC_RELAXED, __HIP_MEMORY_SCOPE_AGENT); }
__device__ __forceinline__ unsigned xb_xcc_id() { return (unsigned)__builtin_amdgcn_s_getreg((3 << 11) | 20) & 0xFu; }
#define XB_SPIN(cond, bar) do { unsigned _sp = 0; while (cond) { __builtin_amdgcn_s_sleep(1); \
    if ((++_sp & 255u) == 0u) { if (xb_ld(&(bar)[XB_TMO])) break; if (_sp > XB_SPIN_CAP) { atomicAdd(&(bar)[XB_TMO], 1u); break; } } } } while (0)

struct XcdBarrier {
    unsigned* bar; unsigned x;
    volatile LAS unsigned* st;
};

__device__ __forceinline__ XcdBarrier xcd_barrier_post(unsigned* bar, volatile LAS unsigned* st) {
    XcdBarrier b; b.bar = bar; b.x = xb_xcc_id(); b.st = st;
    if (threadIdx.x == 0) (void)xb_add(&bar[XB_XCNT(b.x)], 1u);
    return b;
}
__device__ __forceinline__ void xcd_barrier_complete(unsigned* bar, unsigned x, unsigned& nloc, unsigned& nx) {
    const unsigned G = gridDim.x * gridDim.y * gridDim.z;
    unsigned sum, cnt, mine, sp = 0u;
    for (;;) {
        sum = 0u; cnt = 0u; mine = 0u;
#pragma unroll
        for (unsigned j = 0; j < 16; ++j) { const unsigned c = xb_ld(&bar[XB_XCNT(j)]); sum += c; cnt += (c > 0u) ? 1u : 0u; mine = (j == x) ? c : mine; }
        if (sum == G) break;
        __builtin_amdgcn_s_sleep(1);
        if ((++sp & 255u) == 0u) { if (xb_ld(&bar[XB_TMO])) break; if (sp > XB_SPIN_CAP) { atomicAdd(&bar[XB_TMO], 1u); break; } }
    }
    nloc = mine > 0u ? mine : 1u; nx = cnt > 0u ? cnt : 1u;
}

__device__ __forceinline__ void xcd_barrier(const XcdBarrier& b) {
    asm volatile("s_waitcnt vmcnt(0)" ::: "memory");
    __syncthreads();
    if (threadIdx.x == 0) {
        unsigned* bar = b.bar;
        __builtin_amdgcn_s_waitcnt(0);
        unsigned nloc = b.st[0], nx = b.st[1];
        if (nloc == 0u) { xcd_barrier_complete(bar, b.x, nloc, nx); b.st[0] = nloc; b.st[1] = nx; }
        const unsigned old = xb_add(&bar[XB_XSUB(b.x)], 1u);
        const unsigned gen = old / nloc;
        if (old + 1u == (gen + 1u) * nloc) {
            __builtin_amdgcn_fence(__ATOMIC_RELEASE, "agent");
            asm volatile("s_waitcnt vmcnt(0)" ::: "memory");
            const unsigned og = xb_add(&bar[XB_TOP], 1u);
            const unsigned tg = og / nx;
            if (og + 1u == (tg + 1u) * nx) xb_add(&bar[XB_TOPGEN], 1u);
            else XB_SPIN(xb_ld(&bar[XB_TOPGEN]) == tg, bar);
            __builtin_amdgcn_fence(__ATOMIC_ACQUIRE, "agent");
            xb_add(&bar[XB_XGEN(b.x)], 1u);
            asm volatile("s_waitcnt vmcnt(0)" ::: "memory");
        } else {
            XB_SPIN(xb_ld(&bar[XB_XGEN(b.x)]) == gen, bar);
            __builtin_amdgcn_fence(__ATOMIC_ACQUIRE, "agent");
            asm volatile("s_waitcnt vmcnt(0)" ::: "memory");
        }
    }
    __syncthreads();
}


constexpr int DM = 1024, FFD = 4096, INW = 3328;
constexpr int SEQP = 2048, SEQS = 8192, NBP = 16, NBS = 2;
constexpr int RP = NBP * SEQP, RS = NBS * SEQS, R = RP + RS;
constexpr int NMETA = 16, LP = SEQP + NMETA, LS = SEQS + NMETA;
constexpr int N1P = 43, N1S = 171, N2 = 48;
constexpr int UROWS = NBP * LP + NBS * LS;
constexpr float RMS_EPS = 1e-6f, LOG2E = 1.4426950408889634f, QSCALE = 0.125f * 1.4426950408889634f;
constexpr int WINDOW = 128;
#ifndef MK_N_LAUNCHES
#define MK_N_LAUNCHES 1
#endif
constexpr int N_PHASES = 10;

constexpr size_t MiB = 1u << 20;
constexpr size_t WS_CTL = 0, CTL_ZERO_BYTES = 1 * MiB;
constexpr size_t WS_WIN = 2 * MiB, WS_WAO = 9 * MiB, WS_WF = 10 * MiB, WS_WOUT = 12 * MiB, WS_WUP = 14 * MiB, WS_WDN = 22 * MiB;
constexpr size_t WS_SSQ1 = 2 * MiB;
constexpr size_t WS_ROPE = 30 * MiB;
constexpr size_t WS_D1P = 345 * MiB, WS_D1S = WS_D1P + 64 * 1024, WS_D2P = 346 * MiB, WS_D2S = 347 * MiB;
constexpr size_t WS_KMETA = 31 * MiB, WS_VMETA = 31 * MiB + 4096, WS_UMETA = 31 * MiB + 8192;
constexpr size_t WS_G = 32 * MiB, WS_Q = 224 * MiB, WS_K = 272 * MiB, WS_V = 284 * MiB, WS_U = 296 * MiB;
constexpr size_t WS_ACAT = 352 * MiB;
constexpr size_t WS_XN = 352 * MiB;
constexpr size_t WS_MERGED = 224 * MiB;
constexpr size_t WS_TT = 32 * MiB;
constexpr size_t WS_H = 416 * MiB;
constexpr size_t WS_END = 512 * MiB;
static_assert(WS_U + (size_t)UROWS * 512 * 2 <= WS_D1P && WS_D2S + (size_t)N1S * 9216 * 2 <= WS_ACAT && WS_ACAT + (size_t)R * 1536 * 2 <= WS_END && WS_XN + (size_t)(R + 256) * DM * 2 <= WS_END && WS_TT + (size_t)R * FFD * 2 <= WS_H && WS_H + (size_t)R * DM * 2 <= WS_END, "d_ws map");
static_assert(WS_WIN + (size_t)INW * DM * 2 <= WS_WAO && WS_SSQ1 + (size_t)R * 16 * 4 <= WS_WAO, "d_ws map (weights)");
constexpr int CW_BAR = 4096;

constexpr int RING_BYTES = 131072, LDSCTL_OFF = RING_BYTES, MISC_OFF = LDSCTL_OFF + 320, TAB128_OFF = LDSCTL_OFF + 1024, LDS_BYTES = 147456;
constexpr int NWAVES = 8;

__device__ __forceinline__ float bf2f(unsigned short b) { return __builtin_bit_cast(float, (unsigned)b << 16); }
__device__ __forceinline__ float bflo(unsigned u) { return __builtin_bit_cast(float, u << 16); }
__device__ __forceinline__ float bfhi(unsigned u) { return __builtin_bit_cast(float, u & 0xffff0000u); }
__device__ __forceinline__ float wave_sum(float v) {
#pragma unroll
    for (int o = 1; o < 64; o <<= 1) v += __shfl_xor(v, o);
    return v;
}
__device__ __forceinline__ void row_decode(int r, int& seq, int& s, int& S) {
    if (r < RP) { seq = r >> 11; s = r & (SEQP - 1); S = SEQP; } else { const int q = r - RP; seq = NBP + (q >> 13); s = q & (SEQS - 1); S = SEQS; }
}
__device__ __forceinline__ int useq_base(int seq) { return seq < NBP ? seq * LP : NBP * LP + (seq - NBP) * LS; }
__device__ __forceinline__ int rseq_base(int seq) { return seq < NBP ? seq * SEQP : RP + (seq - NBP) * SEQS; }
__device__ __forceinline__ float sigmoidf_fast(float x) { return __builtin_amdgcn_rcpf(1.0f + __builtin_amdgcn_exp2f(-x * LOG2E)); }

typedef pg8::u32x4 u32x4; using pg8::Unit; typedef pg8::bf16_t bf16_t; using pg8::cvt_pk_bf16;
__device__ __forceinline__ u32x4 pack8(const f32x4 a, const f32x4 b) { u32x4 w; w.x = cvt_pk_bf16(a[0], a[1]); w.y = cvt_pk_bf16(a[2], a[3]); w.z = cvt_pk_bf16(b[0], b[1]); w.w = cvt_pk_bf16(b[2], b[3]); return w; }

struct EpiIn {
    static constexpr bool PERM = true, AFTER_DRAIN = false;
    bf16_t *Q, *K, *V, *U, *G, *Km, *Vm, *Um; const float* bgate; const float* rope;
    __device__ __forceinline__ void operator()(const f32x4 (&acc)[2][2][4][2], const Unit& u, int wr, int wc, int fr, int fq) const {
        const int pn = u.pn, rowt = u.pm * 256;
        const bool mt = (u.pm == R / 256);
        int seq, s0, S; row_decode(rowt, seq, s0, S);
        const int ub = useq_base(seq) + NMETA + s0 - rowt;
        if (mt && (wr != 0 || pn < 2 || pn > 4)) return;
#pragma unroll
        for (int ai = 0; ai < 2; ++ai)
#pragma unroll
            for (int m = 0; m < 4; ++m) {
                if (mt && (ai | m)) continue;
                const int rl = ai * 128 + wr * 64 + m * 16 + fr, row = rowt + rl;
#pragma unroll
                for (int bj = 0; bj < 2; ++bj) {
                    f32x4 v0 = acc[ai][bj][m][0], v1 = acc[ai][bj][m][1];
                    const int cc = bj * 128 + wc * 32 + 8 * fq;
                    if (pn < 3 && !(pn == 2 && bj == 1)) {
                        if ((wc & 1) == 0) {
                            f32x4 o0, o1;
#pragma unroll
                            for (int j = 0; j < 4; ++j) { o0[j] = __shfl_xor(v0[j], 16); o1[j] = __shfl_xor(v1[j], 16); }
                            if (fq < 2) {
                                const float* rp = rope + (size_t)(mt ? rl : NMETA + s0 + rl) * 16;
                                const f32x4 c0 = *(const f32x4*)(rp), c1 = *(const f32x4*)(rp + 4), s0v = *(const f32x4*)(rp + 8), s1v = *(const f32x4*)(rp + 12);
                                const float sg = (fq == 0) ? -1.f : 1.f;
                                v0 = v0 * c0 + (o0 * s0v) * sg; v1 = v1 * c1 + (o1 * s1v) * sg;
                            }
                        }
                        if (pn < 2) { v0 = v0 * QSCALE; v1 = v1 * QSCALE; *(u32x4*)(Q + (size_t)row * 512 + pn * 256 + cc) = pack8(v0, v1); }
                        else if (mt) *(u32x4*)(Km + rl * 128 + cc) = pack8(v0, v1);
                        else *(u32x4*)(K + (size_t)row * 128 + cc) = pack8(v0, v1);
                    } else if (pn == 2) {
                        if (mt) *(u32x4*)(Vm + rl * 128 + (cc - 128)) = pack8(v0, v1);
                        else *(u32x4*)(V + (size_t)row * 128 + (cc - 128)) = pack8(v0, v1);
                    } else if (pn < 5) {
                        const u32x4 w = pack8(v0, v1);
                        if (mt) *(u32x4*)(Um + rl * 512 + (pn - 3) * 256 + cc) = w;
                        else *(u32x4*)(U + (size_t)(ub + row) * 512 + (pn - 3) * 256 + cc) = w;
                    } else {
                        const int gc = (pn - 5) * 256 + cc;
                        const f32x4 b0 = *(const f32x4*)(bgate + gc), b1 = *(const f32x4*)(bgate + gc + 4);
#pragma unroll
                        for (int j = 0; j < 4; ++j) { v0[j] = sigmoidf_fast(v0[j] + b0[j]); v1[j] = sigmoidf_fast(v1[j] + b1[j]); }
                        *(u32x4*)(G + (size_t)row * 2048 + gc) = pack8(v0, v1);
                    }
                }
            }
    }
};
struct EpiAO {
    static constexpr bool PERM = true, AFTER_DRAIN = false;
    const bf16_t* G; float* tmp;
    __device__ __forceinline__ void operator()(const f32x4 (&acc)[2][2][4][2], const Unit& u, int wr, int wc, int fr, int fq) const {
#pragma unroll
        for (int ai = 0; ai < 2; ++ai)
#pragma unroll
            for (int m = 0; m < 4; ++m) {
                const int row = u.pm * 256 + ai * 128 + wr * 64 + m * 16 + fr;
#pragma unroll
                for (int bj = 0; bj < 2; ++bj) {
                    const int col = u.pn * 256 + bj * 128 + wc * 32 + 8 * fq;
                    const u32x4 g = *(const u32x4*)(G + (size_t)row * 2048 + col);
                    const f32x4 g0 = {bflo(g.x), bfhi(g.x), bflo(g.y), bfhi(g.y)}, g1 = {bflo(g.z), bfhi(g.z), bflo(g.w), bfhi(g.w)};
                    float* tp = tmp + (size_t)row * DM + col;
                    *(f32x4*)tp = acc[ai][bj][m][0] * g0; *(f32x4*)(tp + 4) = acc[ai][bj][m][1] * g1;
                }
            }
    }
};
struct EpiF {
    static constexpr bool PERM = true, AFTER_DRAIN = false;
    const bf16_t* G; const float* tmp; bf16_t* MG;
    __device__ __forceinline__ void operator()(const f32x4 (&acc)[2][2][4][2], const Unit& u, int wr, int wc, int fr, int fq) const {
#pragma unroll
        for (int ai = 0; ai < 2; ++ai)
#pragma unroll
            for (int m = 0; m < 4; ++m) {
                const int row = u.pm * 256 + ai * 128 + wr * 64 + m * 16 + fr;
#pragma unroll
                for (int bj = 0; bj < 2; ++bj) {
                    const int col = u.pn * 256 + bj * 128 + wc * 32 + 8 * fq;
                    const u32x4 g = *(const u32x4*)(G + (size_t)row * 2048 + 1024 + col);
                    const f32x4 g0 = {bflo(g.x), bfhi(g.x), bflo(g.y), bfhi(g.y)}, g1 = {bflo(g.z), bfhi(g.z), bflo(g.w), bfhi(g.w)};
                    const float* tp = tmp + (size_t)row * DM + col;
                    const f32x4 t0 = *(const f32x4*)tp, t1 = *(const f32x4*)(tp + 4);
                    *(u32x4*)(MG + (size_t)row * DM + col) = pack8(t0 + acc[ai][bj][m][0] * g0, t1 + acc[ai][bj][m][1] * g1);
                }
            }
    }
};
struct EpiOut {
    static constexpr bool PERM = true, AFTER_DRAIN = false;
    const float *xp, *xs; float* h1; bf16_t* H1B; float* ssq;
    __device__ __forceinline__ void operator()(const f32x4 (&acc)[2][2][4][2], const Unit& u, int wr, int wc, int fr, int fq) const {
#pragma unroll
        for (int ai = 0; ai < 2; ++ai)
#pragma unroll
            for (int m = 0; m < 4; ++m) {
                const int row = u.pm * 256 + ai * 128 + wr * 64 + m * 16 + fr;
                const float* xr = (row < RP) ? xp + (size_t)row * DM : xs + (size_t)(row - RP) * DM;
                float sq = 0.f;
#pragma unroll
                for (int bj = 0; bj < 2; ++bj) {
                    const int col = u.pn * 256 + bj * 128 + wc * 32 + 8 * fq;
                    const f32x4 a0 = *(const f32x4*)(xr + col) + acc[ai][bj][m][0], a1 = *(const f32x4*)(xr + col + 4) + acc[ai][bj][m][1];
                    float* hp = h1 + (size_t)row * DM + col; *(f32x4*)hp = a0; *(f32x4*)(hp + 4) = a1;
                    *(u32x4*)(H1B + (size_t)row * DM + col) = pack8(a0, a1);
                    sq += (a0[0] * a0[0] + a0[1] * a0[1]) + (a0[2] * a0[2] + a0[3] * a0[3]) + (a1[0] * a1[0] + a1[1] * a1[1]) + (a1[2] * a1[2] + a1[3] * a1[3]);
                }
                sq += __shfl_xor(sq, 16); sq += __shfl_xor(sq, 32);
                if (fq == 0) ssq[(size_t)row * 16 + u.pn * 4 + wc] = sq;
            }
    }
};
struct EpiUp {
    static constexpr bool PERM = true, AFTER_DRAIN = false;
    const float* ssq; bf16_t* TT;
    __device__ __forceinline__ void operator()(const f32x4 (&acc)[2][2][4][2], const Unit& u, int wr, int wc, int fr, int fq) const {
#pragma unroll
        for (int ai = 0; ai < 2; ++ai)
#pragma unroll
            for (int m = 0; m < 4; ++m) {
                const int row = u.pm * 256 + ai * 128 + wr * 64 + m * 16 + fr;
                const float* sp = ssq + (size_t)row * 16;
                const f32x4 p0 = *(const f32x4*)sp, p1 = *(const f32x4*)(sp + 4), p2 = *(const f32x4*)(sp + 8), p3 = *(const f32x4*)(sp + 12);
                const float tot = (((p0[0] + p0[1]) + (p0[2] + p0[3])) + ((p1[0] + p1[1]) + (p1[2] + p1[3]))) + (((p2[0] + p2[1]) + (p2[2] + p2[3])) + ((p3[0] + p3[1]) + (p3[2] + p3[3])));
                const float rinv = 1.0f / sqrtf(tot * (1.0f / DM) + RMS_EPS);
#pragma unroll
                for (int bj = 0; bj < 2; ++bj) {
                    const int col = u.pn * 256 + bj * 128 + wc * 32 + 8 * fq;
                    f32x4 a0 = acc[ai][bj][m][0] * rinv, a1 = acc[ai][bj][m][1] * rinv;
#pragma unroll
                    for (int j = 0; j < 4; ++j) { a0[j] = fmaxf(a0[j], 0.f); a0[j] *= a0[j]; a1[j] = fmaxf(a1[j], 0.f); a1[j] *= a1[j]; }
                    *(u32x4*)(TT + (size_t)row * FFD + col) = pack8(a0, a1);
                }
            }
    }
};
struct EpiDown {
    static constexpr bool PERM = true, AFTER_DRAIN = false;
    float* h;
    __device__ __forceinline__ void operator()(const f32x4 (&acc)[2][2][4][2], const Unit& u, int wr, int wc, int fr, int fq) const {
#pragma unroll
        for (int ai = 0; ai < 2; ++ai)
#pragma unroll
            for (int m = 0; m < 4; ++m) {
                const int row = u.pm * 256 + ai * 128 + wr * 64 + m * 16 + fr;
#pragma unroll
                for (int bj = 0; bj < 2; ++bj) {
                    const int col = u.pn * 256 + bj * 128 + wc * 32 + 8 * fq;
                    float* hp = h + (size_t)row * DM + col;
                    const f32x4 a0 = *(const f32x4*)hp + acc[ai][bj][m][0], a1 = *(const f32x4*)(hp + 4) + acc[ai][bj][m][1];
                    *(f32x4*)hp = a0; *(f32x4*)(hp + 4) = a1;
                }
            }
    }
};

__device__ __forceinline__ void p0_transpose_item(const float* W, int K, int N, bf16* WT, const float* gk, LAS float* scr, int item, int lane) {
    const int nblk = N / 32, kb = item / nblk, nb = item % nblk, k0 = 64 * kb, n0 = 32 * nb;
#pragma unroll 8
    for (int i = 0; i < 32; ++i) { const int kk = 2 * i + (lane >> 5); float w = W[(size_t)(k0 + kk) * N + n0 + (lane & 31)]; if (gk) w *= gk[k0 + kk]; scr[kk * 33 + (lane & 31)] = w; }
    LDS_WAIT(); asm volatile("" ::: "memory");
    const int c = lane & 7;
#pragma unroll
    for (int j = 0; j < 4; ++j) { const int n = (lane >> 3) + 8 * j; const LAS float* s = scr + (8 * c) * 33 + n;
        v4u o; o.x = pk2(s[0 * 33], s[1 * 33]); o.y = pk2(s[2 * 33], s[3 * 33]); o.z = pk2(s[4 * 33], s[5 * 33]); o.w = pk2(s[6 * 33], s[7 * 33]);
        *(GAS v4u*)(WT + (size_t)(n0 + n) * K + k0 + 8 * c) = o; }
    LDS_WAIT(); asm volatile("" ::: "memory");
}
__device__ __forceinline__ float rope_invfreq(int i) { return powf(500000.0f, -(float)i / 8.0f); }

struct Ptrs {
    const float *xp, *xs, *meta, *gmix, *win, *bgate, *sink, *wao, *wf, *wout, *gmlp, *wup, *wdn, *gfin; float* out;
    bf16 *WinT, *WaoT, *WfT, *WoutT, *WupT, *WdnT, *Gt, *Q, *K, *V, *U, *ACAT, *MG, *TT, *XN, *H1B, *Km, *Vm, *Um, *Y;
    float *ssq1, *rope; bf16 *D1P, *D1S, *D2P, *D2S;
};

__device__ __forceinline__ void p0_prologue(const Ptrs& P, LAS unsigned char* lds, int vcu, int G, int tid, int lane, int wave) {
    LAS float* scr = (LAS float*)(lds + wave * 16384);
    LAS float* t128 = (LAS float*)(lds + TAB128_OFF);
    if (tid < 128) { t128[tid] = cospif((float)tid / 64.0f); t128[128 + tid] = sinpif((float)tid / 64.0f); }
    __syncthreads();
    const int gw = vcu * NWAVES + wave, NGW = G * NWAVES;
    constexpr int I_IN = (DM / 64) * (INW / 32), I_AO = (512 / 64) * (DM / 32), I_OUT = (DM / 64) * (DM / 32), I_UP = (DM / 64) * (FFD / 32), I_DN = (FFD / 64) * (DM / 32);
    constexpr int NT_ITEMS = I_IN + I_AO + I_OUT + I_UP + I_DN;
    for (int it = gw; it < NT_ITEMS; it += NGW) {
        int r = it;
        if (r < I_IN) { p0_transpose_item(P.win, DM, INW, P.WinT, nullptr, scr, r, lane); continue; } r -= I_IN;
        if (r < I_AO) { p0_transpose_item(P.wao, 512, DM, P.WaoT, nullptr, scr, r, lane); continue; } r -= I_AO;
        if (r < I_OUT) { p0_transpose_item(P.wout, DM, DM, P.WoutT, nullptr, scr, r, lane); continue; } r -= I_OUT;
        if (r < I_UP) { p0_transpose_item(P.wup, DM, FFD, P.WupT, P.gmlp, scr, r, lane); continue; } r -= I_UP;
        p0_transpose_item(P.wdn, FFD, DM, P.WdnT, nullptr, scr, r, lane);
    }
    for (int it = gw; it < 4 * 16 * 16; it += NGW) {
        const int g = it >> 8, nb = (it >> 4) & 15, c0 = (it & 15) * 8, n = nb * 64 + lane;
        const float* wp = P.wf + (size_t)(g * 128) * DM + n;
        float sa[8], sb[8];
#pragma unroll
        for (int j = 0; j < 8; ++j) { sa[j] = 0.f; sb[j] = 0.f; }
#pragma unroll 1
        for (int mh = 0; mh < 128; mh += 64) {
            float w[64];
#pragma unroll
            for (int m = 0; m < 64; ++m) w[m] = wp[(size_t)(mh + m) * DM];
#pragma unroll
            for (int j = 0; j < 8; ++j) {
                const int c = c0 + j;
#pragma unroll
                for (int m = 0; m < 64; ++m) { const int ix = (c * (mh + m)) & 127; sa[j] += t128[ix] * w[m]; sb[j] += t128[128 + ix] * w[m]; }
            }
        }
#pragma unroll
        for (int j = 0; j < 8; ++j) {
            P.WfT[(size_t)n * DM + g * 128 + c0 + j] = (bf16)f2bf(sa[j] * 0.08838834764831845f);
            P.WfT[(size_t)n * DM + 512 + g * 128 + c0 + j] = (bf16)f2bf(-sb[j] * 0.08838834764831845f);
        }
    }
    for (int r0 = 2 * gw; r0 < R + 16; r0 += 2 * NGW) {
        const GAS f32x4* g4 = (const GAS f32x4*)P.gmix + lane;
        f32x4 v[2][4]; float s[2];
#pragma unroll
        for (int q = 0; q < 2; ++q) { const int r = r0 + q;
            const float* xr = (r < RP) ? P.xp + (size_t)r * DM : (r < R ? P.xs + (size_t)(r - RP) * DM : P.meta + (size_t)(r - R) * DM);
            const GAS f32x4* x4 = (const GAS f32x4*)xr + lane; s[q] = 0.f;
#pragma unroll
            for (int j = 0; j < 4; ++j) { v[q][j] = x4[64 * j]; s[q] += (v[q][j].x * v[q][j].x + v[q][j].y * v[q][j].y) + (v[q][j].z * v[q][j].z + v[q][j].w * v[q][j].w); } }
#pragma unroll
        for (int q = 0; q < 2; ++q) { const int r = r0 + q;
            const float rinv = 1.0f / sqrtf(wave_sum(s[q]) * (1.0f / DM) + RMS_EPS);
            GAS unsigned long long* o8 = (GAS unsigned long long*)(P.XN + (size_t)r * DM) + lane;
#pragma unroll
            for (int j = 0; j < 4; ++j) { const f32x4 gg = g4[64 * j]; const f32x4 y = v[q][j] * rinv * gg;
                o8[64 * j] = (unsigned long long)pk2(y.x, y.y) | ((unsigned long long)pk2(y.z, y.w) << 32); } }
    }
    for (int r = R + 16 + gw; r < R + 256; r += NGW) { GAS unsigned long long* o8 = (GAS unsigned long long*)(P.XN + (size_t)r * DM) + lane;
#pragma unroll
        for (int j = 0; j < 4; ++j) o8[64 * j] = 0ull; }
    const int gt = (vcu * NWAVES + wave) * 64 + lane, NGT = G * NWAVES * 64;
    for (int e = gt; e < LS * 8; e += NGT) { const int pos = e >> 3, i = e & 7; const float ang = (float)pos * rope_invfreq(i); P.rope[pos * 16 + i] = cosf(ang); P.rope[pos * 16 + 8 + i] = sinf(ang); }
    for (int e = gt; e < 96 * 64; e += NGT) { const int m = e >> 6, l1 = e & 63; float v = 0.f;
        if (m < 2 * N1P && l1 < N1P) { const int k1 = m < N1P ? m : m - N1P; const float t = 2.0f * (float)((k1 * l1) % N1P) / (float)N1P; v = m < N1P ? cospif(t) : -sinpif(t); }
        P.D1P[e] = (bf16)f2bf(v); }
    for (int e = gt; e < 384 * 192; e += NGT) { const int m = e / 192, l1 = e % 192; float v = 0.f;
        if (m < 2 * N1S && l1 < N1S) { const int k1 = m < N1S ? m : m - N1S; const float t = 2.0f * (float)((k1 * l1) % N1S) / (float)N1S; v = m < N1S ? cospif(t) : -sinpif(t); }
        P.D1S[e] = (bf16)f2bf(v); }
    for (int e = gt; e < (N1P + N1S) * 9216; e += NGT) {
        const bool smp = e >= N1P * 9216; const int e2 = smp ? e - N1P * 9216 : e, N1 = smp ? N1S : N1P, L = smp ? LS : LP;
        const int k1 = e2 / 9216, mm = (e2 / 96) % 96, kk = e2 % 96, part = mm >= 48, k2 = mm - 48 * part, ri = kk >= 48, l2 = kk - 48 * ri;
        const int k = k1 + N1 * k2, ix = (l2 * k) % L; const float t = 2.0f * (float)ix / (float)L, c = cospif(t), s = sinpif(t);
        const float v = (part == 0 ? (ri == 0 ? c : s) : (ri == 0 ? s : -c)) / sqrtf((float)L);
        (smp ? P.D2S : P.D2P)[e2] = (bf16)f2bf(v); }
}

typedef float f32x16 __attribute__((ext_vector_type(16)));
typedef short v4i16_t __attribute__((ext_vector_type(4)));
constexpr int AT_KW = 0, AT_VW = 320 * 128, AT_KM = 2 * 320 * 128, AT_VM = AT_KM + 32 * 128;
__device__ __forceinline__ bf16x8 tr_frag(LAS unsigned char* p) {
    const v4i16_t lo = __builtin_amdgcn_ds_read_tr16_b64_v4i16((LAS v4i16_t*)p), hi = __builtin_amdgcn_ds_read_tr16_b64_v4i16((LAS v4i16_t*)(p + 8 * 128));
    return (bf16x8){lo[0], lo[1], lo[2], lo[3], hi[0], hi[1], hi[2], hi[3]};
}
__device__ __forceinline__ void attn_tile(LAS unsigned char* kt, LAS unsigned char* vt, const int mode, const bf16x8 (&qf)[4], f32x16& o0, f32x16& o1, float& m, float& l, const int lane) {
    const int r32 = lane & 31, hi = lane >> 5;
    f32x16 p;
#pragma unroll
    for (int i = 0; i < 16; ++i) p[i] = 0.f;
#pragma unroll
    for (int st = 0; st < 4; ++st) {
        const bf16x8 kf = *(const LAS bf16x8*)(kt + r32 * 128 + (((2 * st + hi) ^ (r32 & 7)) << 4));
        p = __builtin_amdgcn_mfma_f32_32x32x16_bf16(kf, qf[st], p, 0, 0, 0);
    }
    if (mode) {
#pragma unroll
        for (int i = 0; i < 16; ++i) { const int kk = (i & 3) + 8 * (i >> 2) + 4 * hi;
            const bool msk = (mode == 1) ? (kk < r32) : ((mode == 2) ? (kk > r32) : (kk >= 16));
            if (msk) p[i] = -INFINITY; }
    }
    float tm = p[0];
#pragma unroll
    for (int i = 1; i < 16; ++i) tm = fmaxf(tm, p[i]);
    tm = fmaxf(tm, __shfl_xor(tm, 32));
    const float mn = fmaxf(m, tm), a = __builtin_amdgcn_exp2f(m - mn);
    m = mn;
    float ps = 0.f;
#pragma unroll
    for (int i = 0; i < 16; ++i) { p[i] = __builtin_amdgcn_exp2f(p[i] - mn); ps += p[i]; }
    l = l * a + ps;
#pragma unroll
    for (int i = 0; i < 16; ++i) { o0[i] *= a; o1[i] *= a; }
    u32x4 w0, w1;
    w0.x = cvt_pk_bf16(p[0], p[1]); w0.y = cvt_pk_bf16(p[2], p[3]); w0.z = cvt_pk_bf16(p[4], p[5]); w0.w = cvt_pk_bf16(p[6], p[7]);
    w1.x = cvt_pk_bf16(p[8], p[9]); w1.y = cvt_pk_bf16(p[10], p[11]); w1.z = cvt_pk_bf16(p[12], p[13]); w1.w = cvt_pk_bf16(p[14], p[15]);
    const bf16x8 pb0 = __builtin_bit_cast(bf16x8, w0), pb1 = __builtin_bit_cast(bf16x8, w1);
    LAS unsigned char* vb = vt + (4 * hi + ((lane & 15) >> 2)) * 128 + (16 * ((lane >> 4) & 1) + 4 * (lane & 3)) * 2;
    o0 = __builtin_amdgcn_mfma_f32_32x32x16_bf16(tr_frag(vb), pb0, o0, 0, 0, 0);
    o1 = __builtin_amdgcn_mfma_f32_32x32x16_bf16(tr_frag(vb + 64), pb0, o1, 0, 0, 0);
    o0 = __builtin_amdgcn_mfma_f32_32x32x16_bf16(tr_frag(vb + 16 * 128), pb1, o0, 0, 0, 0);
    o1 = __builtin_amdgcn_mfma_f32_32x32x16_bf16(tr_frag(vb + 16 * 128 + 64), pb1, o1, 0, 0, 0);
}
__device__ __forceinline__ void attn_mfma(const Ptrs& P, LAS unsigned char* lds, int vcu, int G, int tid, int lane, int wave) {
    constexpr int NU_P = NBP * 2 * (SEQP / 64), NU = (R / 64) * 2;
    for (int unit = vcu; unit < NU; unit += G) {
        int seq, hk, blk, S;
        if (unit < NU_P) { seq = unit >> 6; hk = (unit >> 5) & 1; blk = unit & 31; S = SEQP; }
        else { const int u2 = unit - NU_P; seq = NBP + (u2 >> 8); hk = (u2 >> 7) & 1; blk = u2 & 127; S = SEQS; }
        const int rb = rseq_base(seq), kw0 = blk * 64 - 128;
        for (int idx = tid; idx < 320 * 8; idx += NWAVES * 64) { const int kl = idx >> 3, c = idx & 7, key = kw0 + kl;
            if (key >= 0 && key < S) { const size_t go = (size_t)(rb + key) * 128 + hk * 64 + c * 8;
                const v4u kv = *(const v4u*)(P.K + go), vv = *(const v4u*)(P.V + go);
                *(LAS v4u*)(lds + AT_KW + kl * 128 + ((c ^ (kl & 7)) << 4)) = kv; *(LAS v4u*)(lds + AT_VW + kl * 128 + (c << 4)) = vv; } }
        if (tid < 256) { const int j = tid >> 3, c = tid & 7; v4u kv = {0u, 0u, 0u, 0u}, vv = {0u, 0u, 0u, 0u};
            if (j < NMETA) { kv = *(const v4u*)(P.Km + j * 128 + hk * 64 + c * 8); vv = *(const v4u*)(P.Vm + j * 128 + hk * 64 + c * 8); }
            *(LAS v4u*)(lds + AT_KM + j * 128 + ((c ^ (j & 7)) << 4)) = kv; *(LAS v4u*)(lds + AT_VM + j * 128 + (c << 4)) = vv; }
        __syncthreads();
        {
            const int g = wave >> 1, half = wave & 1, hq = hk * 4 + g, r32 = lane & 31, hi = lane >> 5;
            const int q0 = blk * 64 + half * 32;
            const size_t qrow = (size_t)(rb + q0 + r32);
            bf16x8 qf[4];
#pragma unroll
            for (int st = 0; st < 4; ++st) qf[st] = *(const bf16x8*)(P.Q + qrow * 512 + hq * 64 + 16 * st + 8 * hi);
            float m = P.sink[hq] * LOG2E, l = hi ? 0.f : 1.f;
            f32x16 o0, o1;
#pragma unroll
            for (int i = 0; i < 16; ++i) { o0[i] = 0.f; o1[i] = 0.f; }
            attn_tile(lds + AT_KM, lds + AT_VM, 3, qf, o0, o1, m, l, lane);
            for (int j = 0; j < 9; ++j) {
                const int key0 = q0 - 128 + 32 * j;
                if (key0 < 0 || key0 >= S) continue;
                const int kl0 = key0 - kw0;
                attn_tile(lds + AT_KW + kl0 * 128, lds + AT_VW + kl0 * 128, j == 0 ? 1 : (j == 8 ? 2 : 0), qf, o0, o1, m, l, lane);
            }
            l += __shfl_xor(l, 32);
            const float il = 1.0f / l;
            bf16* op = P.ACAT + qrow * 1536 + hq * 64 + 4 * hi;
#pragma unroll
            for (int rg = 0; rg < 4; ++rg) {
                uint2 w; w.x = cvt_pk_bf16(o0[4 * rg] * il, o0[4 * rg + 1] * il); w.y = cvt_pk_bf16(o0[4 * rg + 2] * il, o0[4 * rg + 3] * il); *(uint2*)(op + 8 * rg) = w;
                uint2 x; x.x = cvt_pk_bf16(o1[4 * rg] * il, o1[4 * rg + 1] * il); x.y = cvt_pk_bf16(o1[4 * rg + 2] * il, o1[4 * rg + 3] * il); *(uint2*)(op + 32 + 8 * rg) = x;
            }
        }
        __syncthreads();
    }
}

typedef unsigned u32x2_t __attribute__((ext_vector_type(2)));
template <int KS, int NB, class BRow, class Store>
__device__ __forceinline__ void nn96_item(const bf16* Ag, const BRow& brow, const int kreal, const Store& store, LAS unsigned char* lds, int tid, int lane, int wave) {
    constexpr int KP = KS * 32, AST = (KP + 8) * 2, NT = 4 * NB * 16, BST = NT * 2 + 32, A_OFF = 0, B_OFF = 96 * AST;
    static_assert(B_OFF % 16 == 0 && B_OFF + KP * BST <= RING_BYTES, "nn96 LDS");
    for (int idx = tid; idx < 96 * KS * 4; idx += NWAVES * 64) { const int row = idx / (KS * 4), ch = idx % (KS * 4);
        *(LAS v4u*)(lds + A_OFF + row * AST + ch * 16) = *(const v4u*)(Ag + (size_t)row * KP + ch * 8); }
    for (int idx = tid; idx < KP * (NT / 8); idx += NWAVES * 64) { const int row = idx / (NT / 8), ch = idx % (NT / 8); v4u v = {0u, 0u, 0u, 0u};
        if (row < kreal) v = *(const v4u*)(brow(row) + ch * 8);
        *(LAS v4u*)(lds + B_OFF + row * BST + ch * 16) = v; }
    __syncthreads();
    const int wm = wave >> 2, wn = wave & 3, fr = lane & 15, fq = lane >> 4;
    f32x4 acc[3][NB];
#pragma unroll
    for (int mb = 0; mb < 3; ++mb)
#pragma unroll
        for (int nb = 0; nb < NB; ++nb) acc[mb][nb] = (f32x4){0.f, 0.f, 0.f, 0.f};
#pragma unroll
    for (int ks = 0; ks < KS; ++ks) {
        bf16x8 af[3];
#pragma unroll
        for (int mb = 0; mb < 3; ++mb) af[mb] = *(const LAS bf16x8*)(lds + A_OFF + (wm * 48 + mb * 16 + fr) * AST + (ks * 32 + fq * 8) * 2);
#pragma unroll
        for (int nb = 0; nb < NB; ++nb) {
            LAS unsigned char* p = lds + B_OFF + (ks * 32 + 8 * fq + (fr >> 2)) * BST + ((wn * NB + nb) * 16 + 4 * (lane & 3)) * 2;
            const v4i16_t lo = __builtin_amdgcn_ds_read_tr16_b64_v4i16((LAS v4i16_t*)p), hi = __builtin_amdgcn_ds_read_tr16_b64_v4i16((LAS v4i16_t*)(p + 4 * BST));
            const bf16x8 bfr = (bf16x8){lo[0], lo[1], lo[2], lo[3], hi[0], hi[1], hi[2], hi[3]};
#pragma unroll
            for (int mb = 0; mb < 3; ++mb) acc[mb][nb] = __builtin_amdgcn_mfma_f32_16x16x32_bf16(bfr, af[mb], acc[mb][nb], 0, 0, 0);
        }
    }
#pragma unroll
    for (int mb = 0; mb < 3; ++mb)
#pragma unroll
        for (int nb = 0; nb < NB; ++nb) store(wm * 48 + mb * 16 + fr, (wn * NB + nb) * 16 + 4 * fq, acc[mb][nb]);
    __syncthreads();
}
__device__ __forceinline__ u32x2_t pack4(const f32x4 v) { u32x2_t w; w.x = cvt_pk_bf16(v[0], v[1]); w.y = cvt_pk_bf16(v[2], v[3]); return w; }
struct BRowS1 { const bf16* base; const bf16* row0; __device__ __forceinline__ const bf16* operator()(int kk) const { return kk == 0 ? row0 : base + (size_t)kk * (N2 * 512); } };
struct StoreS1 { bf16* base; int mlim, moff; __device__ __forceinline__ void operator()(int m, int n, const f32x4 v) const { const int mg = moff + m; if (mg < mlim) *(u32x2_t*)(base + (size_t)mg * (N2 * 512) + n) = pack4(v); } };
__device__ __forceinline__ void fft_stage1(const Ptrs& P, LAS unsigned char* lds, int vcu, int G, int tid, int lane, int wave) {
    constexpr int IT_P = NBP * 48, IT_S = NBS * 192 * 4;
    for (int it = vcu; it < IT_P + IT_S; it += G) {
        if (it < IT_P) { const int seq = it / 48, nt = it % 48; const size_t ub = (size_t)useq_base(seq) * 512, yb = (size_t)useq_base(seq) * 1024;
            nn96_item<2, 8>(P.D1P, BRowS1{P.U + ub + nt * 512, nt < NMETA ? P.Um + nt * 512 : P.U + ub + nt * 512}, N1P, StoreS1{P.Y + yb + nt * 512, 2 * N1P, 0}, lds, tid, lane, wave); }
        else { const int i2 = it - IT_P, mc = i2 & 3, nt = (i2 >> 2) % 192, seq = NBP + (i2 >> 2) / 192; const size_t ub = (size_t)useq_base(seq) * 512, yb = (size_t)useq_base(seq) * 1024;
            nn96_item<6, 2>(P.D1S + (size_t)mc * 96 * 192, BRowS1{P.U + ub + nt * 128, (nt >> 2) < NMETA ? P.Um + nt * 128 : P.U + ub + nt * 128}, N1S, StoreS1{P.Y + yb + nt * 128, 2 * N1S, mc * 96}, lds, tid, lane, wave); }
    }
}
struct BRowS2 { const bf16* yr; const bf16* yi; __device__ __forceinline__ const bf16* operator()(int kk) const { return kk < 48 ? yr + (size_t)kk * 512 : yi + (size_t)(kk - 48) * 512; } };
struct StoreS2 { bf16* ab; int k1, N1; __device__ __forceinline__ void operator()(int mm, int n, const f32x4 v) const {
    const int part = mm >= 48, k = k1 + N1 * (mm - 48 * part); if (k >= NMETA) *(u32x2_t*)(ab + (size_t)(k - NMETA) * 1536 + part * 512 + n) = pack4(v); } };
__device__ __forceinline__ void fft_stage2(const Ptrs& P, LAS unsigned char* lds, int vcu, int G, int tid, int lane, int wave) {
    constexpr int IT_P = NBP * N1P, IT_S = NBS * N1S;
    for (int it = vcu; it < IT_P + IT_S; it += G) {
        const bool smp = it >= IT_P; const int i2 = smp ? it - IT_P : it, N1 = smp ? N1S : N1P, seq = smp ? NBP + i2 / N1S : i2 / N1P, k1 = smp ? i2 % N1S : i2 % N1P;
        const size_t yb = (size_t)useq_base(seq) * 1024;
        nn96_item<3, 8>((smp ? P.D2S : P.D2P) + (size_t)k1 * 9216, BRowS2{P.Y + yb + (size_t)(k1 * 48) * 512, P.Y + yb + (size_t)((N1 + k1) * 48) * 512}, 96,
                        StoreS2{P.ACAT + 512 + (size_t)rseq_base(seq) * 1536, k1, N1}, lds, tid, lane, wave);
    }
}

struct Args { const float* in[14]; float* out; unsigned char* ws; int ph_lo, ph_hi; };
__global__ void __launch_bounds__(NWAVES * 64, 2) mk_fwd(Args args) {
    extern __shared__ __attribute__((aligned(16))) unsigned char lds_raw[];
    LAS unsigned char* lds = (LAS unsigned char*)lds_raw;
    volatile LAS unsigned* MISC = (volatile LAS unsigned*)(lds + MISC_OFF);
    const int tid = threadIdx.x, lane = tid & 63, wave = __builtin_amdgcn_readfirstlane(tid >> 6);
    const int G = gridDim.x, bx = blockIdx.x, vcu = (G % 8 == 0) ? (bx % 8) * (G / 8) + bx / 8 : bx;
    unsigned char* ws = args.ws;
    gu32* ctl = (gu32*)(ws + WS_CTL);
    Ptrs P;
    P.xp = args.in[0]; P.xs = args.in[1]; P.meta = args.in[2]; P.gmix = args.in[3]; P.win = args.in[4]; P.bgate = args.in[5]; P.sink = args.in[6]; P.wao = args.in[7];
    P.wf = args.in[8]; P.wout = args.in[9]; P.gmlp = args.in[10]; P.wup = args.in[11]; P.wdn = args.in[12]; P.gfin = args.in[13]; P.out = args.out;
    P.WinT = (bf16*)(ws + WS_WIN); P.WaoT = (bf16*)(ws + WS_WAO); P.WfT = (bf16*)(ws + WS_WF); P.WoutT = (bf16*)(ws + WS_WOUT); P.WupT = (bf16*)(ws + WS_WUP); P.WdnT = (bf16*)(ws + WS_WDN);
    P.Gt = (bf16*)(ws + WS_G); P.Q = (bf16*)(ws + WS_Q); P.K = (bf16*)(ws + WS_K); P.V = (bf16*)(ws + WS_V); P.U = (bf16*)(ws + WS_U); P.ACAT = (bf16*)(ws + WS_ACAT);
    P.MG = (bf16*)(ws + WS_MERGED); P.TT = (bf16*)(ws + WS_TT); P.XN = (bf16*)(ws + WS_XN); P.H1B = (bf16*)(ws + WS_H);
    P.Km = (bf16*)(ws + WS_KMETA); P.Vm = (bf16*)(ws + WS_VMETA); P.Um = (bf16*)(ws + WS_UMETA); P.Y = (bf16*)args.out;
    P.ssq1 = (float*)(ws + WS_SSQ1); P.rope = (float*)(ws + WS_ROPE);
    P.D1P = (bf16*)(ws + WS_D1P); P.D1S = (bf16*)(ws + WS_D1S); P.D2P = (bf16*)(ws + WS_D2P); P.D2S = (bf16*)(ws + WS_D2S);

    for (int u = tid; u < (LDS_BYTES - LDSCTL_OFF) / 4; u += NWAVES * 64) ((LAS unsigned*)(lds + LDSCTL_OFF))[u] = 0u;
    __syncthreads();
    XcdBarrier bar; bar.bar = (unsigned*)(ctl + CW_BAR); bar.x = 0; bar.st = nullptr;
    if (MK_N_LAUNCHES == 1) bar = xcd_barrier_post((unsigned*)(ctl + CW_BAR), MISC + 8);
    const int lo = args.ph_lo, hi = args.ph_hi;
#define IN(k) (lo <= (k) && (k) < hi)
#ifndef PROBE_PHASE
#define PROBE_PHASE (-1)
#endif
#ifndef PROBE_MULT
#define PROBE_MULT 2
#endif
    unsigned long long tph0 = (PROBE_PHASE >= 0) ? rt() : 0ull;
#define PH_END(k) do { if (PROBE_PHASE == (k)) { const unsigned long long t1_ = rt(); const unsigned long long d_ = (t1_ - tph0) * PROBE_MULT; while (rt() - t1_ < d_) __builtin_amdgcn_s_sleep(8); } if (PROBE_PHASE >= 0) tph0 = rt(); } while (0)
#define SEAM(k) do { if (IN(k) && IN((k) + 1)) xcd_barrier(bar); } while (0)
    const int gw = vcu * NWAVES + wave, NGW = G * NWAVES;

    if (IN(0)) { p0_prologue(P, lds, vcu, G, tid, lane, wave); SEAM(0); PH_END(0); }
    if (IN(1)) {
        pg8::Gemm g{P.XN, P.WinT, R + 256, INW, DM, DM}; pg8::StaticOrder S; S.init(R + 256, INW, G, bx);
        EpiIn E{P.Q, P.K, P.V, P.U, P.Gt, P.Km, P.Vm, P.Um, P.bgate, P.rope};
        pg8::gemm_phase<EpiIn, pg8::StaticOrder, true, true>(lds, g, S, E);
        SEAM(1); PH_END(1);
    }
    if (IN(2)) {
        attn_mfma(P, lds, vcu, G, tid, lane, wave);
        fft_stage1(P, lds, vcu, G, tid, lane, wave);
        SEAM(2); PH_END(2);
    }
    if (IN(3)) {
        fft_stage2(P, lds, vcu, G, tid, lane, wave);
        SEAM(3); PH_END(3);
    }
    if (IN(4)) {
        pg8::Gemm g{P.ACAT, P.WaoT, R, DM, 512, 1536}; pg8::StaticOrder S; S.init(R, DM, G, bx);
        EpiAO E{P.Gt, P.out};
        pg8::gemm_phase<EpiAO, pg8::StaticOrder, true, true>(lds, g, S, E);
        SEAM(4); PH_END(4);
    }
    if (IN(5)) {
        pg8::Gemm g{P.ACAT + 512, P.WfT, R, DM, DM, 1536}; pg8::StaticOrder S; S.init(R, DM, G, bx);
        EpiF E{P.Gt, P.out, P.MG};
        pg8::gemm_phase<EpiF, pg8::StaticOrder, true, true>(lds, g, S, E);
        SEAM(5); PH_END(5);
    }
    if (IN(6)) {
        pg8::Gemm g{P.MG, P.WoutT, R, DM, DM, DM}; pg8::StaticOrder S; S.init(R, DM, G, bx);
        EpiOut E{P.xp, P.xs, P.out, P.H1B, P.ssq1};
        pg8::gemm_phase<EpiOut, pg8::StaticOrder, true, true>(lds, g, S, E);
        SEAM(6); PH_END(6);
    }
    if (IN(7)) {
        pg8::Gemm g{P.H1B, P.WupT, R, FFD, DM, DM}; pg8::StaticOrder S; S.init(R, FFD, G, bx);
        EpiUp E{P.ssq1, P.TT};
        pg8::gemm_phase<EpiUp, pg8::StaticOrder, true, true>(lds, g, S, E);
        SEAM(7); PH_END(7);
    }
    if (IN(8)) {
        pg8::Gemm g{P.TT, P.WdnT, R, DM, FFD, FFD}; pg8::StaticOrder S; S.init(R, DM, G, bx);
        EpiDown E{P.out};
        pg8::gemm_phase<EpiDown, pg8::StaticOrder, true, true>(lds, g, S, E);
        SEAM(8); PH_END(8);
    }
    if (IN(9)) {
        for (int r = gw; r < R; r += NGW) {
            GAS f32x4* h4 = (GAS f32x4*)(P.out + (size_t)r * DM) + lane; const GAS f32x4* g4 = (const GAS f32x4*)P.gfin + lane;
            f32x4 v[4]; float s = 0.f;
#pragma unroll
            for (int j = 0; j < 4; ++j) { v[j] = h4[64 * j]; s += (v[j].x * v[j].x + v[j].y * v[j].y) + (v[j].z * v[j].z + v[j].w * v[j].w); }
            const float rinv = 1.0f / sqrtf(wave_sum(s) * (1.0f / DM) + RMS_EPS);
#pragma unroll
            for (int j = 0; j < 4; ++j) h4[64 * j] = v[j] * rinv * g4[64 * j];
        }
        PH_END(9);
    }
#undef IN
#undef SEAM
}

extern "C" void kernel_launch(void* const* d_in, const int* in_sizes, int n_in, void* d_out, int out_size, void* d_ws, size_t ws_size, hipStream_t stream) {
    static int grid = 0;
    if (grid == 0) {
        if (n_in != 14 || in_sizes[0] != RP * DM || in_sizes[1] != RS * DM || out_size != R * DM || ws_size < WS_END) {
            fprintf(stderr, "kernel_launch: unexpected shapes: n_in %d in0 %d in1 %d out %d ws %zu (need >= %zu); nothing launched\n", n_in, n_in > 0 ? in_sizes[0] : -1, n_in > 1 ? in_sizes[1] : -1, out_size, ws_size, (size_t)WS_END);
            grid = -1; return; }
        int dev = 0, cus = 0;
        if (hipGetDevice(&dev) != hipSuccess || hipDeviceGetAttribute(&cus, hipDeviceAttributeMultiprocessorCount, dev) != hipSuccess) { grid = -1; return; }
        if (hipFuncSetAttribute((const void*)mk_fwd, hipFuncAttributeMaxDynamicSharedMemorySize, LDS_BYTES) != hipSuccess) { fprintf(stderr, "kernel_launch: hipFuncSetAttribute failed\n"); grid = -1; return; }
        int per_cu = 0;
        if (hipOccupancyMaxActiveBlocksPerMultiprocessor(&per_cu, (const void*)mk_fwd, NWAVES * 64, LDS_BYTES) != hipSuccess || per_cu < 1)
            fprintf(stderr, "kernel_launch: note: occupancy query reports %d workgroups per CU\n", per_cu);
        (void)hipGetLastError();
        grid = cus;
    }
    if (grid < 0) return;
    if (hipMemsetAsync((char*)d_ws + WS_CTL, 0, CTL_ZERO_BYTES, stream) != hipSuccess) { fprintf(stderr, "kernel_launch: memset failed\n"); return; }
    Args a{};
    for (int i = 0; i < 14; ++i) a.in[i] = (const float*)d_in[i];
    a.out = (float*)d_out; a.ws = (unsigned char*)d_ws;
    if (MK_N_LAUNCHES == 1) { a.ph_lo = 0; a.ph_hi = N_PHASES; hipLaunchKernelGGL(mk_fwd, dim3(grid), dim3(NWAVES * 64), LDS_BYTES, stream, a); }
    else for (int p = 0; p < N_PHASES; ++p) { a.ph_lo = p; a.ph_hi = p + 1; hipLaunchKernelGGL(mk_fwd, dim3(grid), dim3(NWAVES * 64), LDS_BYTES, stream, a); }
    const hipError_t le = hipPeekAtLastError();
    if (le != hipSuccess) fprintf(stderr, "kernel_launch: launch failed: %s\n", hipGetErrorName(le));
}
```

```cpp
#include <hip/hip_runtime.h>
#include <cstdio>
#include <cstdint>
#include <cmath>
namespace pg8 {
#define PG8_LAS __attribute__((address_space(3)))
typedef unsigned short bf16_t;
typedef short bf16x8 __attribute__((ext_vector_type(8)));
typedef float f32x4 __attribute__((ext_vector_type(4)));
typedef unsigned u32x4 __attribute__((ext_vector_type(4)));
constexpr int BM = 256, BK = 64, HALF = 128, HTB = HALF * BK * 2  , STAGE_BYTES = 8 * HTB, NXCD = 8, WGM = 8;

__host__ __device__ __forceinline__ int lds_byte(int r, int c) { const int st = (r >> 4) * 2 + (c >> 5), rr = r & 15, cc = c & 31, ob = rr * 64 + cc * 2; return st * 1024 + (ob ^ (((ob >> 9) & 1) << 5)); }
__host__ __device__ __forceinline__ void stage_rc(int b, int& R, int& C) { const int st = b / 1024, sb = b % 1024, swz = sb ^ (((sb >> 9) & 1) << 5); R = (st >> 1) * 16 + swz / 64; C = (st & 1) * 32 + (swz % 64) / 2; }
__host__ __device__ __forceinline__ int perm32(int rho) { const int n = rho >> 4, i = rho & 15; return 8 * (i >> 2) + 4 * n + (i & 3); }

struct Unit { int pm, pn; };
struct Gemm { const bf16_t* A; const bf16_t* Bt; int M, N, K, lda; };

struct StaticOrder {
    int nM, nN, nwg, G, c;
    __host__ __device__ void init(int M, int N, int G_, int c_) { nM = M / BM; nN = N / BM; nwg = nM * nN; G = G_; c = c_; }
    __host__ __device__ bool next(int i, Unit& u) const {
        const long L = (long)i * G + c; if (L >= nwg) return false;
        int wgid = (int)L; { const int q = nwg / NXCD, r = nwg % NXCD, xcd = wgid % NXCD, off = wgid / NXCD; wgid = (xcd < r ? xcd * (q + 1) : r * (q + 1) + (xcd - r) * q) + off; }
        const int nig = WGM * nN, gid = wgid / nig, fm = gid * WGM, gsz = (nM - fm) < WGM ? (nM - fm) : WGM;
        u.pm = fm + ((wgid % nig) % gsz); u.pn = (wgid % nig) / gsz; return true;
    }
    __device__ __forceinline__ void a_ready(const Unit&) const {}
    __device__ __forceinline__ void done(const Unit&) const {}
};

__device__ __forceinline__ unsigned cvt_pk_bf16(float lo, float hi) { unsigned r; asm volatile("v_cvt_pk_bf16_f32 %0, %1, %2" : "=v"(r) : "v"(lo), "v"(hi)); return r; }
typedef float f32x2 __attribute__((ext_vector_type(2)));
template <class Epi, class Sched, bool ALIGN_EPI = false, bool SP2 = false>
__device__ __forceinline__ void gemm_phase(PG8_LAS unsigned char* lds, const Gemm g, const Sched& S, const Epi& E) {
    const int tid = threadIdx.x, wid = __builtin_amdgcn_readfirstlane(tid >> 6), lane = tid & 63, wr = wid >> 2, wc = wid & 3, fr = lane & 15, fq = lane >> 4;
    const int K = g.K, nt = K / BK;
    unsigned voffA[2], voffB[2];
#pragma unroll
    for (int i = 0; i < 2; ++i) { int R, C; stage_rc(tid * 16 + i * 8192, R, C); const int Rb = Epi::PERM ? ((R & ~31) + perm32(R & 31)) : R;
        voffA[i] = (unsigned)(R * g.lda + C) * 2u; voffB[i] = (unsigned)(Rb * K + C) * 2u; }
    const size_t kstep = (size_t)(BK * 2);
    const size_t hstep = (size_t)HALF * K * 2;
    const size_t tstep = 2 * hstep;
    const size_t hstepA = (size_t)HALF * g.lda * 2, tstepA = 2 * hstepA;
    const unsigned ldsw = (unsigned)wid * 1024u;
    const int aoff = lds_byte(wr * 64 + fr, fq * 8), boff = lds_byte(wc * 32 + fr, fq * 8);
#define PG8_SA(b, h) (((b) * 2 + (h)) * HTB)
#define PG8_SB(b, h) ((4 + (b) * 2 + (h)) * HTB)
#define PG8_STAGE(bufoff, gbase, voff) do { _Pragma("unroll") for (int _i = 0; _i < 2; ++_i) \
        __builtin_amdgcn_global_load_lds((const unsigned*)((const char*)(gbase) + (voff)[_i]), (PG8_LAS unsigned*)(lds + (bufoff) + ldsw + _i * 8192), 16, 0, 0); } while (0)
#define PG8_LDA(dst, b, h) do { _Pragma("unroll") for (int m = 0; m < 4; ++m) _Pragma("unroll") for (int k = 0; k < 2; ++k) dst[m][k] = *(const PG8_LAS bf16x8*)(lds + PG8_SA(b, h) + aoff + m * 2048 + k * 1024); } while (0)
#define PG8_LDB(dst, b, h) do { _Pragma("unroll") for (int n = 0; n < 2; ++n) _Pragma("unroll") for (int k = 0; k < 2; ++k) dst[n][k] = *(const PG8_LAS bf16x8*)(lds + PG8_SB(b, h) + boff + n * 2048 + k * 1024); } while (0)
#define PG8_MMA(ai, bj, At, Bt) do { __builtin_amdgcn_s_setprio(1); _Pragma("unroll") for (int m = 0; m < 4; ++m) _Pragma("unroll") for (int n = 0; n < 2; ++n) _Pragma("unroll") for (int k = 0; k < 2; ++k) \
        acc[ai][bj][m][n] = __builtin_amdgcn_mfma_f32_16x16x32_bf16(Bt[n][k], At[m][k], acc[ai][bj][m][n], 0, 0, 0); __builtin_amdgcn_s_setprio(0); } while (0)
#define PG8_WAIT_V(n) asm volatile("s_waitcnt vmcnt(" #n ")" ::: "memory")
#define PG8_WAIT_L(n) asm volatile("s_waitcnt lgkmcnt(" #n ")" ::: "memory")
#define PG8_BAR __builtin_amdgcn_s_barrier()
#define PG8_SCHED __builtin_amdgcn_sched_barrier(0)
    Unit cur, nxt; int ui = 0;
    if (!S.next(0, cur)) return;
    f32x4 acc[2][2][4][2];
#pragma unroll
    for (int a = 0; a < 2; ++a)
#pragma unroll
        for (int b = 0; b < 2; ++b)
#pragma unroll
            for (int m = 0; m < 4; ++m)
#pragma unroll
                for (int n = 0; n < 2; ++n) acc[a][b][m][n] = (f32x4){0.f, 0.f, 0.f, 0.f};
    bf16x8 At[4][2], B0[2][2], B1[2][2];
    const char* cA = (const char*)g.A + (size_t)cur.pm * tstepA; const char* cB = (const char*)g.Bt + (size_t)cur.pn * tstep;
    S.a_ready(cur);
    if constexpr (SP2) {
        PG8_STAGE(PG8_SB(0, 0), cB, voffB); PG8_STAGE(PG8_SB(0, 1), cB + hstep, voffB); PG8_STAGE(PG8_SA(0, 0), cA, voffA); PG8_STAGE(PG8_SA(0, 1), cA + hstepA, voffA);
        if (wr == 1) PG8_BAR;
        PG8_WAIT_V(2); PG8_BAR;
        PG8_STAGE(PG8_SB(1, 0), cB + kstep, voffB); PG8_STAGE(PG8_SA(1, 0), cA + kstep, voffA); PG8_STAGE(PG8_SB(1, 1), cB + hstep + kstep, voffB);
        PG8_WAIT_V(6); PG8_BAR;
    } else {
        PG8_STAGE(PG8_SB(0, 0), cB, voffB); PG8_STAGE(PG8_SA(0, 0), cA, voffA); PG8_STAGE(PG8_SB(0, 1), cB + hstep, voffB); PG8_STAGE(PG8_SA(0, 1), cA + hstepA, voffA);
        if (wr == 1) PG8_BAR;
        PG8_WAIT_V(4); PG8_BAR;
        PG8_STAGE(PG8_SB(1, 0), cB + kstep, voffB); PG8_STAGE(PG8_SA(1, 0), cA + kstep, voffA); PG8_STAGE(PG8_SB(1, 1), cB + hstep + kstep, voffB);
        PG8_WAIT_V(6); PG8_BAR;
    }
    for (;;) {
        const bool has_next = S.next(ui + 1, nxt);
        const char* nA = has_next ? (const char*)g.A + (size_t)nxt.pm * tstepA : cA; const char* nB = has_next ? (const char*)g.Bt + (size_t)nxt.pn * tstep : cB;
        for (int t = 0; t < nt; t += 2) {
            const bool last = (t == nt - 2);
            const char* a1 = cA + (size_t)(t + 1) * kstep;
            const char* a2 = last ? nA : cA + (size_t)(t + 2) * kstep; const char* b2 = last ? nB : cB + (size_t)(t + 2) * kstep;
            const char* a3 = a2 + kstep; const char* b3 = b2 + kstep;
            if (last && has_next) S.a_ready(nxt);
            if constexpr (SP2) {
            PG8_LDB(B0, 0, 0); PG8_LDB(B1, 0, 1); PG8_SCHED; PG8_LDA(At, 0, 0); PG8_STAGE(PG8_SA(1, 1), a1 + hstepA, voffA);
            PG8_WAIT_V(8); PG8_WAIT_L(0); PG8_BAR; PG8_MMA(0, 0, At, B0); PG8_MMA(0, 1, At, B1); PG8_BAR; PG8_SCHED;
            PG8_LDA(At, 0, 1); PG8_STAGE(PG8_SB(0, 0), b2, voffB); PG8_STAGE(PG8_SB(0, 1), b2 + hstep, voffB); PG8_STAGE(PG8_SA(0, 0), a2, voffA);
            PG8_WAIT_V(8); PG8_WAIT_L(0); PG8_BAR; PG8_MMA(1, 0, At, B0); PG8_MMA(1, 1, At, B1); PG8_BAR; PG8_SCHED;
            PG8_LDB(B0, 1, 0); PG8_LDB(B1, 1, 1); PG8_SCHED; PG8_LDA(At, 1, 0); PG8_STAGE(PG8_SA(0, 1), a2 + hstepA, voffA);
            PG8_WAIT_V(8); PG8_WAIT_L(0); PG8_BAR; PG8_MMA(0, 0, At, B0); PG8_MMA(0, 1, At, B1); PG8_BAR; PG8_SCHED;
            PG8_LDA(At, 1, 1); PG8_STAGE(PG8_SB(1, 0), b3, voffB); PG8_STAGE(PG8_SB(1, 1), b3 + hstep, voffB); PG8_STAGE(PG8_SA(1, 0), a3, voffA);
            PG8_WAIT_V(8); PG8_WAIT_L(0); PG8_BAR; PG8_MMA(1, 0, At, B0); PG8_MMA(1, 1, At, B1); PG8_BAR; PG8_SCHED;
            } else {
            PG8_LDB(B0, 0, 0); PG8_SCHED; PG8_LDA(At, 0, 0); PG8_STAGE(PG8_SA(1, 1), a1 + hstepA, voffA);
            PG8_WAIT_L(8); PG8_BAR; PG8_WAIT_L(0); PG8_MMA(0, 0, At, B0); PG8_BAR; PG8_SCHED;
            PG8_LDB(B1, 0, 1); PG8_STAGE(PG8_SB(0, 0), b2, voffB);
            PG8_BAR; PG8_WAIT_L(0); PG8_MMA(0, 1, At, B1); PG8_BAR;
            PG8_LDA(At, 0, 1); PG8_STAGE(PG8_SA(0, 0), a2, voffA);
            PG8_BAR; PG8_WAIT_L(0); PG8_MMA(1, 0, At, B0); PG8_BAR; PG8_SCHED;
            PG8_STAGE(PG8_SB(0, 1), b2 + hstep, voffB);
            PG8_WAIT_V(6); PG8_BAR; PG8_MMA(1, 1, At, B1); PG8_BAR;
            PG8_LDB(B0, 1, 0); PG8_SCHED; PG8_LDA(At, 1, 0); PG8_STAGE(PG8_SA(0, 1), a2 + hstepA, voffA);
            PG8_WAIT_L(8); PG8_BAR; PG8_WAIT_L(0); PG8_MMA(0, 0, At, B0); PG8_BAR; PG8_SCHED;
            PG8_LDB(B1, 1, 1); PG8_STAGE(PG8_SB(1, 0), b3, voffB);
            PG8_BAR; PG8_WAIT_L(0); PG8_MMA(0, 1, At, B1); PG8_BAR;
            PG8_LDA(At, 1, 1); PG8_STAGE(PG8_SA(1, 0), a3, voffA);
            PG8_BAR; PG8_WAIT_L(0); PG8_MMA(1, 0, At, B0); PG8_BAR; PG8_SCHED;
            PG8_STAGE(PG8_SB(1, 1), b3 + hstep, voffB);
            PG8_WAIT_V(6); PG8_BAR; PG8_MMA(1, 1, At, B1); PG8_BAR;
            }
        }
        if constexpr (ALIGN_EPI) { if (wr == 0) PG8_BAR; }
        if constexpr (!Epi::AFTER_DRAIN) { E(acc, cur, wr, wc, fr, fq); S.done(cur); }
        if (!has_next) break;
#pragma unroll
        for (int a = 0; a < 2; ++a)
#pragma unroll
            for (int b = 0; b < 2; ++b)
#pragma unroll
                for (int m = 0; m < 4; ++m)
#pragma unroll
                    for (int n = 0; n < 2; ++n) acc[a][b][m][n] = (f32x4){0.f, 0.f, 0.f, 0.f};
        cur = nxt; cA = nA; cB = nB; ++ui;
        if constexpr (ALIGN_EPI) { if (wr == 1) PG8_BAR; }
    }
    PG8_WAIT_V(0);
    if constexpr (!ALIGN_EPI) { if (wr == 0) PG8_BAR; }
    PG8_BAR;
    if constexpr (Epi::AFTER_DRAIN) { E.fused(acc, cur, wr, wc, fr, fq, lds, wid, lane); S.done(cur); }
#undef PG8_SA
#undef PG8_SB
#undef PG8_STAGE
#undef PG8_LDA
#undef PG8_LDB
#undef PG8_MMA
#undef PG8_WAIT_V
#undef PG8_WAIT_L
#undef PG8_BAR
#undef PG8_SCHED
}
}

#define GAS __attribute__((address_space(1)))
#define LAS __attribute__((address_space(3)))
typedef unsigned short bf16;
typedef unsigned v4u __attribute__((ext_vector_type(4)));
typedef float f32x4 __attribute__((ext_vector_type(4)));
typedef short bf16x8 __attribute__((ext_vector_type(8)));
typedef GAS unsigned gu32;
typedef GAS unsigned long long gu64;
#define RLX_AGENT __ATOMIC_RELAXED, __HIP_MEMORY_SCOPE_AGENT
#define LDS_WAIT() asm volatile("s_waitcnt lgkmcnt(0)" ::: "memory")
#define VM_WAIT() asm volatile("s_waitcnt vmcnt(0)" ::: "memory")
__device__ __forceinline__ unsigned long long rt() { return __builtin_amdgcn_s_memrealtime(); }
__device__ __forceinline__ unsigned f2bf(float f) { unsigned u = __builtin_bit_cast(unsigned, f); return (u + 0x7fffu + ((u >> 16) & 1u)) >> 16; }
__device__ __forceinline__ unsigned pk2(float lo, float hi) { return f2bf(lo) | (f2bf(hi) << 16); }
#define XB_TMO      128
#define XB_XCNT(j)  (256  + 64 * (j))
#define XB_XSUB(j)  (1280 + 64 * (j))
#define XB_XGEN(j)  (2304 + 64 * (j))
#define XB_TOP      3328
#define XB_TOPGEN   3392
#define XCD_BAR_WORDS 3456
#define XB_SPIN_CAP (1u << 18)

__device__ __forceinline__ unsigned xb_ld(unsigned* p)              { return __hip_atomic_load(p, __ATOMIC_RELAXED, __HIP_MEMORY_SCOPE_AGENT); }
__device__ __forceinline__ unsigned xb_add(unsigned* p, unsigned v) { return __hip_atomic_fetch_add(p, v, __ATOMIC_RELAXED, __HIP_MEMORY_SCOPE_AGENT); }
__device__ __forceinline__ unsigned xb_xcc_id() { return (unsigned)__builtin_amdgcn_s_getreg((3 << 11) | 20) & 0xFu; }
#define XB_SPIN(cond, bar) do { unsigned _sp = 0; while (cond) { __builtin_amdgcn_s_sleep(1); \
    if ((++_sp & 255u) == 0u) { if (xb_ld(&(bar)[XB_TMO])) break; if (_sp > XB_SPIN_CAP) { atomicAdd(&(bar)[XB_TMO], 1u); break; } } } } while (0)

struct XcdBarrier {
    unsigned* bar; unsigned x;
    volatile LAS unsigned* st;
};

__device__ __forceinline__ XcdBarrier xcd_barrier_post(unsigned* bar, volatile LAS unsigned* st) {
    XcdBarrier b; b.bar = bar; b.x = xb_xcc_id(); b.st = st;
    if (threadIdx.x == 0) (void)xb_add(&bar[XB_XCNT(b.x)], 1u);
    return b;
}
__device__ __forceinline__ void xcd_barrier_complete(unsigned* bar, unsigned x, unsigned& nloc, unsigned& nx) {
    const unsigned G = gridDim.x * gridDim.y * gridDim.z;
    unsigned sum, cnt, mine, sp = 0u;
    for (;;) {
        sum = 0u; cnt = 0u; mine = 0u;
#pragma unroll
        for (unsigned j = 0; j < 16; ++j) { const unsigned c = xb_ld(&bar[XB_XCNT(j)]); sum += c; cnt += (c > 0u) ? 1u : 0u; mine = (j == x) ? c : mine; }
        if (sum == G) break;
        __builtin_amdgcn_s_sleep(1);
        if ((++sp & 255u) == 0u) { if (xb_ld(&bar[XB_TMO])) break; if (sp > XB_SPIN_CAP) { atomicAdd(&bar[XB_TMO], 1u); break; } }
    }
    nloc = mine > 0u ? mine : 1u; nx = cnt > 0u ? cnt : 1u;
}

__device__ __forceinline__ void xcd_barrier(const XcdBarrier& b) {
    asm volatile("s_waitcnt vmcnt(0)" ::: "memory");
    __syncthreads();
    if (threadIdx.x == 0) {
        unsigned* bar = b.bar;
        __builtin_amdgcn_s_waitcnt(0);
        unsigned nloc = b.st[0], nx = b.st[1];
        if (nloc == 0u) { xcd_barrier_complete(bar, b.x, nloc, nx); b.st[0] = nloc; b.st[1] = nx; }
        const unsigned old = xb_add(&bar[XB_XSUB(b.x)], 1u);
        const unsigned gen = old / nloc;
        if (old + 1u == (gen + 1u) * nloc) {
            __builtin_amdgcn_fence(__ATOMIC_RELEASE, "agent");
            asm volatile("s_waitcnt vmcnt(0)" ::: "memory");
            const unsigned og = xb_add(&bar[XB_TOP], 1u);
            const unsigned tg = og / nx;
            if (og + 1u == (tg + 1u) * nx) xb_add(&bar[XB_TOPGEN], 1u);
            else XB_SPIN(xb_ld(&bar[XB_TOPGEN]) == tg, bar);
            __builtin_amdgcn_fence(__ATOMIC_ACQUIRE, "agent");
            xb_add(&bar[XB_XGEN(b.x)], 1u);
            asm volatile("s_waitcnt vmcnt(0)" ::: "memory");
        } else {
            XB_SPIN(xb_ld(&bar[XB_XGEN(b.x)]) == gen, bar);
            __builtin_amdgcn_fence(__ATOMIC_ACQUIRE, "agent");
            asm volatile("s_waitcnt vmcnt(0)" ::: "memory");
        }
    }
    __syncthreads();
}


constexpr int DM = 1024, FFD = 4096, INW = 3328;
constexpr int SEQP = 2048, SEQS = 8192, NBP = 16, NBS = 2;
constexpr int RP = NBP * SEQP, RS = NBS * SEQS, R = RP + RS;
constexpr int NMETA = 16, LP = SEQP + NMETA, LS = SEQS + NMETA;
constexpr int N1P = 43, N1S = 171, N2 = 48;
constexpr int UROWS = NBP * LP + NBS * LS;
constexpr float RMS_EPS = 1e-6f, LOG2E = 1.4426950408889634f, QSCALE = 0.125f * 1.4426950408889634f;
constexpr int WINDOW = 128;
#ifndef MK_N_LAUNCHES
#define MK_N_LAUNCHES 1
#endif
constexpr int N_PHASES = 10;

constexpr size_t MiB = 1u << 20;
constexpr size_t WS_CTL = 0, CTL_ZERO_BYTES = 1 * MiB;
constexpr size_t WS_WIN = 2 * MiB, WS_WAO = 9 * MiB, WS_WF = 10 * MiB, WS_WOUT = 12 * MiB, WS_WUP = 14 * MiB, WS_WDN = 22 * MiB;
constexpr size_t WS_SSQ1 = 2 * MiB;
constexpr size_t WS_ROPE = 30 * MiB;
constexpr size_t WS_D1P = 345 * MiB, WS_D1S = WS_D1P + 64 * 1024, WS_D2P = 346 * MiB, WS_D2S = 347 * MiB;
constexpr size_t WS_KMETA = 31 * MiB, WS_VMETA = 31 * MiB + 4096, WS_UMETA = 31 * MiB + 8192;
constexpr size_t WS_G = 32 * MiB, WS_Q = 224 * MiB, WS_K = 272 * MiB, WS_V = 284 * MiB, WS_U = 296 * MiB;
constexpr size_t WS_ACAT = 352 * MiB;
constexpr size_t WS_XN = 352 * MiB;
constexpr size_t WS_MERGED = 224 * MiB;
constexpr size_t WS_TT = 32 * MiB;
constexpr size_t WS_H = 416 * MiB;
constexpr size_t WS_END = 512 * MiB;
static_assert(WS_U + (size_t)UROWS * 512 * 2 <= WS_D1P && WS_D2S + (size_t)N1S * 9216 * 2 <= WS_ACAT && WS_ACAT + (size_t)R * 1536 * 2 <= WS_END && WS_XN + (size_t)(R + 256) * DM * 2 <= WS_END && WS_TT + (size_t)R * FFD * 2 <= WS_H && WS_H + (size_t)R * DM * 2 <= WS_END, "d_ws map");
static_assert(WS_WIN + (size_t)INW * DM * 2 <= WS_WAO && WS_SSQ1 + (size_t)R * 16 * 4 <= WS_WAO, "d_ws map (weights)");
constexpr int CW_BAR = 4096;

constexpr int RING_BYTES = 131072, LDSCTL_OFF = RING_BYTES, MISC_OFF = LDSCTL_OFF + 320, TAB128_OFF = LDSCTL_OFF + 1024, LDS_BYTES = 147456;
constexpr int NWAVES = 8;

__device__ __forceinline__ float bf2f(unsigned short b) { return __builtin_bit_cast(float, (unsigned)b << 16); }
__device__ __forceinline__ float bflo(unsigned u) { return __builtin_bit_cast(float, u << 16); }
__device__ __forceinline__ float bfhi(unsigned u) { return __builtin_bit_cast(float, u & 0xffff0000u); }
__device__ __forceinline__ float wave_sum(float v) {
#pragma unroll
    for (int o = 1; o < 64; o <<= 1) v += __shfl_xor(v, o);
    return v;
}
__device__ __forceinline__ void row_decode(int r, int& seq, int& s, int& S) {
    if (r < RP) { seq = r >> 11; s = r & (SEQP - 1); S = SEQP; } else { const int q = r - RP; seq = NBP + (q >> 13); s = q & (SEQS - 1); S = SEQS; }
}
__device__ __forceinline__ int useq_base(int seq) { return seq < NBP ? seq * LP : NBP * LP + (seq - NBP) * LS; }
__device__ __forceinline__ int rseq_base(int seq) { return seq < NBP ? seq * SEQP : RP + (seq - NBP) * SEQS; }
__device__ __forceinline__ float sigmoidf_fast(float x) { return __builtin_amdgcn_rcpf(1.0f + __builtin_amdgcn_exp2f(-x * LOG2E)); }

typedef pg8::u32x4 u32x4; using pg8::Unit; typedef pg8::bf16_t bf16_t; using pg8::cvt_pk_bf16;
__device__ __forceinline__ u32x4 pack8(const f32x4 a, const f32x4 b) { u32x4 w; w.x = cvt_pk_bf16(a[0], a[1]); w.y = cvt_pk_bf16(a[2], a[3]); w.z = cvt_pk_bf16(b[0], b[1]); w.w = cvt_pk_bf16(b[2], b[3]); return w; }

struct EpiIn {
    static constexpr bool PERM = true, AFTER_DRAIN = false;
    bf16_t *Q, *K, *V, *U, *G, *Km, *Vm, *Um; const float* bgate; const float* rope;
    __device__ __forceinline__ void operator()(const f32x4 (&acc)[2][2][4][2], const Unit& u, int wr, int wc, int fr, int fq) const {
        const int pn = u.pn, rowt = u.pm * 256;
        const bool mt = (u.pm == R / 256);
        int seq, s0, S; row_decode(rowt, seq, s0, S);
        const int ub = useq_base(seq) + NMETA + s0 - rowt;
        if (mt && (wr != 0 || pn < 2 || pn > 4)) return;
#pragma unroll
        for (int ai = 0; ai < 2; ++ai)
#pragma unroll
            for (int m = 0; m < 4; ++m) {
                if (mt && (ai | m)) continue;
                const int rl = ai * 128 + wr * 64 + m * 16 + fr, row = rowt + rl;
#pragma unroll
                for (int bj = 0; bj < 2; ++bj) {
                    f32x4 v0 = acc[ai][bj][m][0], v1 = acc[ai][bj][m][1];
                    const int cc = bj * 128 + wc * 32 + 8 * fq;
                    if (pn < 3 && !(pn == 2 && bj == 1)) {
                        if ((wc & 1) == 0) {
                            f32x4 o0, o1;
#pragma unroll
                            for (int j = 0; j < 4; ++j) { o0[j] = __shfl_xor(v0[j], 16); o1[j] = __shfl_xor(v1[j], 16); }
                            if (fq < 2) {
                                const float* rp = rope + (size_t)(mt ? rl : NMETA + s0 + rl) * 16;
                                const f32x4 c0 = *(const f32x4*)(rp), c1 = *(const f32x4*)(rp + 4), s0v = *(const f32x4*)(rp + 8), s1v = *(const f32x4*)(rp + 12);
                                const float sg = (fq == 0) ? -1.f : 1.f;
                                v0 = v0 * c0 + (o0 * s0v) * sg; v1 = v1 * c1 + (o1 * s1v) * sg;
                            }
                        }
                        if (pn < 2) { v0 = v0 * QSCALE; v1 = v1 * QSCALE; *(u32x4*)(Q + (size_t)row * 512 + pn * 256 + cc) = pack8(v0, v1); }
                        else if (mt) *(u32x4*)(Km + rl * 128 + cc) = pack8(v0, v1);
                        else *(u32x4*)(K + (size_t)row * 128 + cc) = pack8(v0, v1);
                    } else if (pn == 2) {
                        if (mt) *(u32x4*)(Vm + rl * 128 + (cc - 128)) = pack8(v0, v1);
                        else *(u32x4*)(V + (size_t)row * 128 + (cc - 128)) = pack8(v0, v1);
                    } else if (pn < 5) {
                        const u32x4 w = pack8(v0, v1);
                        if (mt) *(u32x4*)(Um + rl * 512 + (pn - 3) * 256 + cc) = w;
                        else *(u32x4*)(U + (size_t)(ub + row) * 512 + (pn - 3) * 256 + cc) = w;
                    } else {
                        const int gc = (pn - 5) * 256 + cc;
                        const f32x4 b0 = *(const f32x4*)(bgate + gc), b1 = *(const f32x4*)(bgate + gc + 4);
#pragma unroll
                        for (int j = 0; j < 4; ++j) { v0[j] = sigmoidf_fast(v0[j] + b0[j]); v1[j] = sigmoidf_fast(v1[j] + b1[j]); }
                        *(u32x4*)(G + (size_t)row * 2048 + gc) = pack8(v0, v1);
                    }
                }
            }
    }
};
struct EpiAO {
    static constexpr bool PERM = true, AFTER_DRAIN = false;
    const bf16_t* G; float* tmp;
    __device__ __forceinline__ void operator()(const f32x4 (&acc)[2][2][4][2], const Unit& u, int wr, int wc, int fr, int fq) const {
#pragma unroll
        for (int ai = 0; ai < 2; ++ai)
#pragma unroll
            for (int m = 0; m < 4; ++m) {
                const int row = u.pm * 256 + ai * 128 + wr * 64 + m * 16 + fr;
#pragma unroll
                for (int bj = 0; bj < 2; ++bj) {
                    const int col = u.pn * 256 + bj * 128 + wc * 32 + 8 * fq;
                    const u32x4 g = *(const u32x4*)(G + (size_t)row * 2048 + col);
                    const f32x4 g0 = {bflo(g.x), bfhi(g.x), bflo(g.y), bfhi(g.y)}, g1 = {bflo(g.z), bfhi(g.z), bflo(g.w), bfhi(g.w)};
                    float* tp = tmp + (size_t)row * DM + col;
                    *(f32x4*)tp = acc[ai][bj][m][0] * g0; *(f32x4*)(tp + 4) = acc[ai][bj][m][1] * g1;
                }
            }
    }
};
struct EpiF {
    static constexpr bool PERM = true, AFTER_DRAIN = false;
    const bf16_t* G; const float* tmp; bf16_t* MG;
    __device__ __forceinline__ void operator()(const f32x4 (&acc)[2][2][4][2], const Unit& u, int wr, int wc, int fr, int fq) const {
#pragma unroll
        for (int ai = 0; ai < 2; ++ai)
#pragma unroll
            for (int m = 0; m < 4; ++m) {
                const int row = u.pm * 256 + ai * 128 + wr * 64 + m * 16 + fr;
#pragma unroll
                for (int bj = 0; bj < 2; ++bj) {
                    const int col = u.pn * 256 + bj * 128 + wc * 32 + 8 * fq;
                    const u32x4 g = *(const u32x4*)(G + (size_t)row * 2048 + 1024 + col);
                    const f32x4 g0 = {bflo(g.x), bfhi(g.x), bflo(g.y), bfhi(g.y)}, g1 = {bflo(g.z), bfhi(g.z), bflo(g.w), bfhi(g.w)};
                    const float* tp = tmp + (size_t)row * DM + col;
                    const f32x4 t0 = *(const f32x4*)tp, t1 = *(const f32x4*)(tp + 4);
                    *(u32x4*)(MG + (size_t)row * DM + col) = pack8(t0 + acc[ai][bj][m][0] * g0, t1 + acc[ai][bj][m][1] * g1);
                }
            }
    }
};
struct EpiOut {
    static constexpr bool PERM = true, AFTER_DRAIN = false;
    const float *xp, *xs; float* h1; bf16_t* H1B; float* ssq;
    __device__ __forceinline__ void operator()(const f32x4 (&acc)[2][2][4][2], const Unit& u, int wr, int wc, int fr, int fq) const {
#pragma unroll
        for (int ai = 0; ai < 2; ++ai)
#pragma unroll
            for (int m = 0; m < 4; ++m) {
                const int row = u.pm * 256 + ai * 128 + wr * 64 + m * 16 + fr;
                const float* xr = (row < RP) ? xp + (size_t)row * DM : xs + (size_t)(row - RP) * DM;
                float sq = 0.f;
#pragma unroll
                for (int bj = 0; bj < 2; ++bj) {
                    const int col = u.pn * 256 + bj * 128 + wc * 32 + 8 * fq;
                    const f32x4 a0 = *(const f32x4*)(xr + col) + acc[ai][bj][m][0], a1 = *(const f32x4*)(xr + col + 4) + acc[ai][bj][m][1];
                    float* hp = h1 + (size_t)row * DM + col; *(f32x4*)hp = a0; *(f32x4*)(hp + 4) = a1;
                    *(u32x4*)(H1B + (size_t)row * DM + col) = pack8(a0, a1);
                    sq += (a0[0] * a0[0] + a0[1] * a0[1]) + (a0[2] * a0[2] + a0[3] * a0[3]) + (a1[0] * a1[0] + a1[1] * a1[1]) + (a1[2] * a1[2] + a1[3] * a1[3]);
                }
                sq += __shfl_xor(sq, 16); sq += __shfl_xor(sq, 32);
                if (fq == 0) ssq[(size_t)row * 16 + u.pn * 4 + wc] = sq;
            }
    }
};
struct EpiUp {
    static constexpr bool PERM = true, AFTER_DRAIN = false;
    const float* ssq; bf16_t* TT;
    __device__ __forceinline__ void operator()(const f32x4 (&acc)[2][2][4][2], const Unit& u, int wr, int wc, int fr, int fq) const {
#pragma unroll
        for (int ai = 0; ai < 2; ++ai)
#pragma unroll
            for (int m = 0; m < 4; ++m) {
                const int row = u.pm * 256 + ai * 128 + wr * 64 + m * 16 + fr;
                const float* sp = ssq + (size_t)row * 16;
                const f32x4 p0 = *(const f32x4*)sp, p1 = *(const f32x4*)(sp + 4), p2 = *(const f32x4*)(sp + 8), p3 = *(const f32x4*)(sp + 12);
                const float tot = (((p0[0] + p0[1]) + (p0[2] + p0[3])) + ((p1[0] + p1[1]) + (p1[2] + p1[3]))) + (((p2[0] + p2[1]) + (p2[2] + p2[3])) + ((p3[0] + p3[1]) + (p3[2] + p3[3])));
                const float rinv = 1.0f / sqrtf(tot * (1.0f / DM) + RMS_EPS);
#pragma unroll
                for (int bj = 0; bj < 2; ++bj) {
                    const int col = u.pn * 256 + bj * 128 + wc * 32 + 8 * fq;
                    f32x4 a0 = acc[ai][bj][m][0] * rinv, a1 = acc[ai][bj][m][1] * rinv;
#pragma unroll
                    for (int j = 0; j < 4; ++j) { a0[j] = fmaxf(a0[j], 0.f); a0[j] *= a0[j]; a1[j] = fmaxf(a1[j], 0.f); a1[j] *= a1[j]; }
                    *(u32x4*)(TT + (size_t)row * FFD + col) = pack8(a0, a1);
                }
            }
    }
};
struct EpiDown {
    static constexpr bool PERM = true, AFTER_DRAIN = false;
    float* h;
    __device__ __forceinline__ void operator()(const f32x4 (&acc)[2][2][4][2], const Unit& u, int wr, int wc, int fr, int fq) const {
#pragma unroll
        for (int ai = 0; ai < 2; ++ai)
#pragma unroll
            for (int m = 0; m < 4; ++m) {
                const int row = u.pm * 256 + ai * 128 + wr * 64 + m * 16 + fr;
#pragma unroll
                for (int bj = 0; bj < 2; ++bj) {
                    const int col = u.pn * 256 + bj * 128 + wc * 32 + 8 * fq;
                    float* hp = h + (size_t)row * DM + col;
                    const f32x4 a0 = *(const f32x4*)hp + acc[ai][bj][m][0], a1 = *(const f32x4*)(hp + 4) + acc[ai][bj][m][1];
                    *(f32x4*)hp = a0; *(f32x4*)(hp + 4) = a1;
                }
            }
    }
};

__device__ __forceinline__ void p0_transpose_item(const float* W, int K, int N, bf16* WT, const float* gk, LAS float* scr, int item, int lane) {
    const int nblk = N / 32, kb = item / nblk, nb = item % nblk, k0 = 64 * kb, n0 = 32 * nb;
    const int nch = lane & 7, kr = lane >> 3;
#pragma unroll
    for (int i = 0; i < 8; ++i) { const int kk = 8 * i + kr; f32x4 w = *(const GAS f32x4*)(W + (size_t)(k0 + kk) * N + n0 + 4 * nch); if (gk) w = w * gk[k0 + kk];
        LAS float* d = scr + kk * 33 + 4 * nch; d[0] = w.x; d[1] = w.y; d[2] = w.z; d[3] = w.w; }
    LDS_WAIT(); asm volatile("" ::: "memory");
    const int c = lane & 7;
#pragma unroll
    for (int j = 0; j < 4; ++j) { const int n = (lane >> 3) + 8 * j; const LAS float* s = scr + (8 * c) * 33 + n;
        v4u o; o.x = pk2(s[0 * 33], s[1 * 33]); o.y = pk2(s[2 * 33], s[3 * 33]); o.z = pk2(s[4 * 33], s[5 * 33]); o.w = pk2(s[6 * 33], s[7 * 33]);
        *(GAS v4u*)(WT + (size_t)(n0 + n) * K + k0 + 8 * c) = o; }
    LDS_WAIT(); asm volatile("" ::: "memory");
}
__device__ __forceinline__ float rope_invfreq(int i) { return powf(500000.0f, -(float)i / 8.0f); }

struct Ptrs {
    const float *xp, *xs, *meta, *gmix, *win, *bgate, *sink, *wao, *wf, *wout, *gmlp, *wup, *wdn, *gfin; float* out;
    bf16 *WinT, *WaoT, *WfT, *WoutT, *WupT, *WdnT, *Gt, *Q, *K, *V, *U, *ACAT, *MG, *TT, *XN, *H1B, *Km, *Vm, *Um, *Y;
    float *ssq1, *rope; bf16 *D1P, *D1S, *D2P, *D2S;
};

__device__ __forceinline__ void p0_prologue(const Ptrs& P, LAS unsigned char* lds, int vcu, int G, int tid, int lane, int wave) {
    LAS float* scr = (LAS float*)(lds + wave * 16384);
    LAS float* t128 = (LAS float*)(lds + TAB128_OFF);
    if (tid < 128) { t128[tid] = cospif((float)tid / 64.0f); t128[128 + tid] = sinpif((float)tid / 64.0f); }
    __syncthreads();
    const bool roleX = wave < 4; const int gw = vcu * 4 + (wave & 3), NGW = G * 4;
    if (!roleX) {
    constexpr int I_IN = (DM / 64) * (INW / 32), I_AO = (512 / 64) * (DM / 32), I_OUT = (DM / 64) * (DM / 32), I_UP = (DM / 64) * (FFD / 32), I_DN = (FFD / 64) * (DM / 32);
    constexpr int NT_ITEMS = I_IN + I_AO + I_OUT + I_UP + I_DN;
    for (int it = gw; it < NT_ITEMS; it += NGW) {
        int r = it;
        if (r < I_IN) { p0_transpose_item(P.win, DM, INW, P.WinT, nullptr, scr, r, lane); continue; } r -= I_IN;
        if (r < I_AO) { p0_transpose_item(P.wao, 512, DM, P.WaoT, nullptr, scr, r, lane); continue; } r -= I_AO;
        if (r < I_OUT) { p0_transpose_item(P.wout, DM, DM, P.WoutT, nullptr, scr, r, lane); continue; } r -= I_OUT;
        if (r < I_UP) { p0_transpose_item(P.wup, DM, FFD, P.WupT, P.gmlp, scr, r, lane); continue; } r -= I_UP;
        p0_transpose_item(P.wdn, FFD, DM, P.WdnT, nullptr, scr, r, lane);
    }
    for (int it = gw; it < 4 * 16 * 16; it += NGW) {
        const int g = it >> 8, nb = (it >> 4) & 15, c0 = (it & 15) * 8, n = nb * 64 + lane;
        const float* wp = P.wf + (size_t)(g * 128) * DM + n;
        float sa[8], sb[8];
#pragma unroll
        for (int j = 0; j < 8; ++j) { sa[j] = 0.f; sb[j] = 0.f; }
#pragma unroll 1
        for (int mh = 0; mh < 128; mh += 64) {
            float w[64];
#pragma unroll
            for (int m = 0; m < 64; ++m) w[m] = wp[(size_t)(mh + m) * DM];
#pragma unroll
            for (int j = 0; j < 8; ++j) {
                const int c = c0 + j;
#pragma unroll
                for (int m = 0; m < 64; ++m) { const int ix = (c * (mh + m)) & 127; sa[j] += t128[ix] * w[m]; sb[j] += t128[128 + ix] * w[m]; }
            }
        }
#pragma unroll
        for (int j = 0; j < 8; ++j) {
            P.WfT[(size_t)n * DM + g * 128 + c0 + j] = (bf16)f2bf(sa[j] * 0.08838834764831845f);
            P.WfT[(size_t)n * DM + 512 + g * 128 + c0 + j] = (bf16)f2bf(-sb[j] * 0.08838834764831845f);
        }
    }
    } else {
    for (int r0 = 4 * gw; r0 < R + 16; r0 += 4 * NGW) {
        const GAS f32x4* g4 = (const GAS f32x4*)P.gmix + lane;
        f32x4 v[4][4]; float s[4];
#pragma unroll
        for (int q = 0; q < 4; ++q) { const int r = r0 + q;
            const float* xr = (r < RP) ? P.xp + (size_t)r * DM : (r < R ? P.xs + (size_t)(r - RP) * DM : P.meta + (size_t)(r - R) * DM);
            const GAS f32x4* x4 = (const GAS f32x4*)xr + lane; s[q] = 0.f;
#pragma unroll
            for (int j = 0; j < 4; ++j) { v[q][j] = x4[64 * j]; s[q] += (v[q][j].x * v[q][j].x + v[q][j].y * v[q][j].y) + (v[q][j].z * v[q][j].z + v[q][j].w * v[q][j].w); } }
#pragma unroll
        for (int q = 0; q < 4; ++q) { const int r = r0 + q;
            const float rinv = 1.0f / sqrtf(wave_sum(s[q]) * (1.0f / DM) + RMS_EPS);
            GAS unsigned long long* o8 = (GAS unsigned long long*)(P.XN + (size_t)r * DM) + lane;
#pragma unroll
            for (int j = 0; j < 4; ++j) { const f32x4 gg = g4[64 * j]; const f32x4 y = v[q][j] * rinv * gg;
                o8[64 * j] = (unsigned long long)pk2(y.x, y.y) | ((unsigned long long)pk2(y.z, y.w) << 32); } }
    }
    for (int r = R + 16 + gw; r < R + 256; r += NGW) { GAS unsigned long long* o8 = (GAS unsigned long long*)(P.XN + (size_t)r * DM) + lane;
#pragma unroll
        for (int j = 0; j < 4; ++j) o8[64 * j] = 0ull; }
    }
    if (!roleX) {
    const int gt = gw * 64 + lane, NGT = NGW * 64;
    for (int e = gt; e < LS * 8; e += NGT) { const int pos = e >> 3, i = e & 7; const float ang = (float)pos * rope_invfreq(i); P.rope[pos * 16 + i] = cosf(ang); P.rope[pos * 16 + 8 + i] = sinf(ang); }
    for (int e = gt; e < 96 * 64; e += NGT) { const int m = e >> 6, l1 = e & 63; float v = 0.f;
        if (m < 2 * N1P && l1 < N1P) { const int k1 = m < N1P ? m : m - N1P; const float t = 2.0f * (float)((k1 * l1) % N1P) / (float)N1P; v = m < N1P ? cospif(t) : -sinpif(t); }
        P.D1P[e] = (bf16)f2bf(v); }
    for (int e = gt; e < 384 * 192; e += NGT) { const int m = e / 192, l1 = e % 192; float v = 0.f;
        if (m < 2 * N1S && l1 < N1S) { const int k1 = m < N1S ? m : m - N1S; const float t = 2.0f * (float)((k1 * l1) % N1S) / (float)N1S; v = m < N1S ? cospif(t) : -sinpif(t); }
        P.D1S[e] = (bf16)f2bf(v); }
    for (int e = gt; e < (N1P + N1S) * 9216; e += NGT) {
        const bool smp = e >= N1P * 9216; const int e2 = smp ? e - N1P * 9216 : e, N1 = smp ? N1S : N1P, L = smp ? LS : LP;
        const int k1 = e2 / 9216, mm = (e2 / 96) % 96, kk = e2 % 96, part = mm >= 48, k2 = mm - 48 * part, ri = kk >= 48, l2 = kk - 48 * ri;
        const int k = k1 + N1 * k2, ix = (l2 * k) % L; const float t = 2.0f * (float)ix / (float)L, c = cospif(t), s = sinpif(t);
        const float v = (part == 0 ? (ri == 0 ? c : s) : (ri == 0 ? s : -c)) / sqrtf((float)L);
        (smp ? P.D2S : P.D2P)[e2] = (bf16)f2bf(v); }
    }
}

typedef float f32x16 __attribute__((ext_vector_type(16)));
typedef short v4i16_t __attribute__((ext_vector_type(4)));
constexpr int AT_KW = 0, AT_VW = 320 * 128, AT_KM = 2 * 320 * 128, AT_VM = AT_KM + 32 * 128;
__device__ __forceinline__ bf16x8 tr_frag(LAS unsigned char* p) {
    const v4i16_t lo = __builtin_amdgcn_ds_read_tr16_b64_v4i16((LAS v4i16_t*)p), hi = __builtin_amdgcn_ds_read_tr16_b64_v4i16((LAS v4i16_t*)(p + 8 * 128));
    return (bf16x8){lo[0], lo[1], lo[2], lo[3], hi[0], hi[1], hi[2], hi[3]};
}
__device__ __forceinline__ void attn_tile(LAS unsigned char* kt, LAS unsigned char* vt, const int mode, const bf16x8 (&qf)[4], f32x16& o0, f32x16& o1, float& m, float& l, const int lane) {
    const int r32 = lane & 31, hi = lane >> 5;
    f32x16 p;
#pragma unroll
    for (int i = 0; i < 16; ++i) p[i] = 0.f;
#pragma unroll
    for (int st = 0; st < 4; ++st) {
        const bf16x8 kf = *(const LAS bf16x8*)(kt + r32 * 128 + (((2 * st + hi) ^ (r32 & 7)) << 4));
        p = __builtin_amdgcn_mfma_f32_32x32x16_bf16(kf, qf[st], p, 0, 0, 0);
    }
    if (mode) {
#pragma unroll
        for (int i = 0; i < 16; ++i) { const int kk = (i & 3) + 8 * (i >> 2) + 4 * hi;
            const bool msk = (mode == 1) ? (kk < r32) : ((mode == 2) ? (kk > r32) : (kk >= 16));
            if (msk) p[i] = -INFINITY; }
    }
    float tm = p[0];
#pragma unroll
    for (int i = 1; i < 16; ++i) tm = fmaxf(tm, p[i]);
    tm = fmaxf(tm, __shfl_xor(tm, 32));
    const float mn = fmaxf(m, tm), a = __builtin_amdgcn_exp2f(m - mn);
    m = mn;
    float ps = 0.f;
#pragma unroll
    for (int i = 0; i < 16; ++i) { p[i] = __builtin_amdgcn_exp2f(p[i] - mn); ps += p[i]; }
    l = l * a + ps;
#pragma unroll
    for (int i = 0; i < 16; ++i) { o0[i] *= a; o1[i] *= a; }
    u32x4 w0, w1;
    w0.x = cvt_pk_bf16(p[0], p[1]); w0.y = cvt_pk_bf16(p[2], p[3]); w0.z = cvt_pk_bf16(p[4], p[5]); w0.w = cvt_pk_bf16(p[6], p[7]);
    w1.x = cvt_pk_bf16(p[8], p[9]); w1.y = cvt_pk_bf16(p[10], p[11]); w1.z = cvt_pk_bf16(p[12], p[13]); w1.w = cvt_pk_bf16(p[14], p[15]);
    const bf16x8 pb0 = __builtin_bit_cast(bf16x8, w0), pb1 = __builtin_bit_cast(bf16x8, w1);
    LAS unsigned char* vb = vt + (4 * hi + ((lane & 15) >> 2)) * 128 + (16 * ((lane >> 4) & 1) + 4 * (lane & 3)) * 2;
    o0 = __builtin_amdgcn_mfma_f32_32x32x16_bf16(tr_frag(vb), pb0, o0, 0, 0, 0);
    o1 = __builtin_amdgcn_mfma_f32_32x32x16_bf16(tr_frag(vb + 64), pb0, o1, 0, 0, 0);
    o0 = __builtin_amdgcn_mfma_f32_32x32x16_bf16(tr_frag(vb + 16 * 128), pb1, o0, 0, 0, 0);
    o1 = __builtin_amdgcn_mfma_f32_32x32x16_bf16(tr_frag(vb + 16 * 128 + 64), pb1, o1, 0, 0, 0);
}
__device__ __forceinline__ void attn_mfma(const Ptrs& P, LAS unsigned char* lds, int vcu, int G, int tid, int lane, int wave) {
    constexpr int NU_P = NBP * 2 * (SEQP / 64), NU = (R / 64) * 2;
    for (int unit = vcu; unit < NU; unit += G) {
        int seq, hk, blk, S;
        if (unit < NU_P) { seq = unit >> 6; hk = (unit >> 5) & 1; blk = unit & 31; S = SEQP; }
        else { const int u2 = unit - NU_P; seq = NBP + (u2 >> 8); hk = (u2 >> 7) & 1; blk = u2 & 127; S = SEQS; }
        const int rb = rseq_base(seq), kw0 = blk * 64 - 128;
        for (int idx = tid; idx < 320 * 8; idx += NWAVES * 64) { const int kl = idx >> 3, c = idx & 7, key = kw0 + kl;
            if (key >= 0 && key < S) { const size_t go = (size_t)(rb + key) * 128 + hk * 64 + c * 8;
                const v4u kv = *(const v4u*)(P.K + go), vv = *(const v4u*)(P.V + go);
                *(LAS v4u*)(lds + AT_KW + kl * 128 + ((c ^ (kl & 7)) << 4)) = kv; *(LAS v4u*)(lds + AT_VW + kl * 128 + (c << 4)) = vv; } }
        if (tid < 256) { const int j = tid >> 3, c = tid & 7; v4u kv = {0u, 0u, 0u, 0u}, vv = {0u, 0u, 0u, 0u};
            if (j < NMETA) { kv = *(const v4u*)(P.Km + j * 128 + hk * 64 + c * 8); vv = *(const v4u*)(P.Vm + j * 128 + hk * 64 + c * 8); }
            *(LAS v4u*)(lds + AT_KM + j * 128 + ((c ^ (j & 7)) << 4)) = kv; *(LAS v4u*)(lds + AT_VM + j * 128 + (c << 4)) = vv; }
        __syncthreads();
        {
            const int g = wave >> 1, half = wave & 1, hq = hk * 4 + g, r32 = lane & 31, hi = lane >> 5;
            const int q0 = blk * 64 + half * 32;
            const size_t qrow = (size_t)(rb + q0 + r32);
            bf16x8 qf[4];
#pragma unroll
            for (int st = 0; st < 4; ++st) qf[st] = *(const bf16x8*)(P.Q + qrow * 512 + hq * 64 + 16 * st + 8 * hi);
            float m = P.sink[hq] * LOG2E, l = hi ? 0.f : 1.f;
            f32x16 o0, o1;
#pragma unroll
            for (int i = 0; i < 16; ++i) { o0[i] = 0.f; o1[i] = 0.f; }
            attn_tile(lds + AT_KM, lds + AT_VM, 3, qf, o0, o1, m, l, lane);
            for (int j = 0; j < 9; ++j) {
                const int key0 = q0 - 128 + 32 * j;
                if (key0 < 0 || key0 >= S) continue;
                const int kl0 = key0 - kw0;
                attn_tile(lds + AT_KW + kl0 * 128, lds + AT_VW + kl0 * 128, j == 0 ? 1 : (j == 8 ? 2 : 0), qf, o0, o1, m, l, lane);
            }
            l += __shfl_xor(l, 32);
            const float il = 1.0f / l;
            bf16* op = P.ACAT + qrow * 1536 + hq * 64 + 4 * hi;
#pragma unroll
            for (int rg = 0; rg < 4; ++rg) {
                uint2 w; w.x = cvt_pk_bf16(o0[4 * rg] * il, o0[4 * rg + 1] * il); w.y = cvt_pk_bf16(o0[4 * rg + 2] * il, o0[4 * rg + 3] * il); *(uint2*)(op + 8 * rg) = w;
                uint2 x; x.x = cvt_pk_bf16(o1[4 * rg] * il, o1[4 * rg + 1] * il); x.y = cvt_pk_bf16(o1[4 * rg + 2] * il, o1[4 * rg + 3] * il); *(uint2*)(op + 32 + 8 * rg) = x;
            }
        }
        __syncthreads();
    }
}

typedef unsigned u32x2_t __attribute__((ext_vector_type(2)));
template <int KS, int NB, class BRow, class Store>
__device__ __forceinline__ void nn96_item(const bf16* Ag, const BRow& brow, const int kreal, const Store& store, LAS unsigned char* lds, int tid, int lane, int wave) {
    constexpr int KP = KS * 32, AST = (KP + 8) * 2, NT = 4 * NB * 16, BST = NT * 2 + 32, A_OFF = 0, B_OFF = 96 * AST;
    static_assert(B_OFF % 16 == 0 && B_OFF + KP * BST <= RING_BYTES, "nn96 LDS");
    for (int idx = tid; idx < 96 * KS * 4; idx += NWAVES * 64) { const int row = idx / (KS * 4), ch = idx % (KS * 4);
        *(LAS v4u*)(lds + A_OFF + row * AST + ch * 16) = *(const v4u*)(Ag + (size_t)row * KP + ch * 8); }
    for (int idx = tid; idx < KP * (NT / 8); idx += NWAVES * 64) { const int row = idx / (NT / 8), ch = idx % (NT / 8); v4u v = {0u, 0u, 0u, 0u};
        if (row < kreal) v = *(const v4u*)(brow(row) + ch * 8);
        *(LAS v4u*)(lds + B_OFF + row * BST + ch * 16) = v; }
    __syncthreads();
    const int wm = wave >> 2, wn = wave & 3, fr = lane & 15, fq = lane >> 4;
    f32x4 acc[3][NB];
#pragma unroll
    for (int mb = 0; mb < 3; ++mb)
#pragma unroll
        for (int nb = 0; nb < NB; ++nb) acc[mb][nb] = (f32x4){0.f, 0.f, 0.f, 0.f};
#pragma unroll
    for (int ks = 0; ks < KS; ++ks) {
        bf16x8 af[3];
#pragma unroll
        for (int mb = 0; mb < 3; ++mb) af[mb] = *(const LAS bf16x8*)(lds + A_OFF + (wm * 48 + mb * 16 + fr) * AST + (ks * 32 + fq * 8) * 2);
#pragma unroll
        for (int nb = 0; nb < NB; ++nb) {
            LAS unsigned char* p = lds + B_OFF + (ks * 32 + 8 * fq + (fr >> 2)) * BST + ((wn * NB + nb) * 16 + 4 * (lane & 3)) * 2;
            const v4i16_t lo = __builtin_amdgcn_ds_read_tr16_b64_v4i16((LAS v4i16_t*)p), hi = __builtin_amdgcn_ds_read_tr16_b64_v4i16((LAS v4i16_t*)(p + 4 * BST));
            const bf16x8 bfr = (bf16x8){lo[0], lo[1], lo[2], lo[3], hi[0], hi[1], hi[2], hi[3]};
#pragma unroll
            for (int mb = 0; mb < 3; ++mb) acc[mb][nb] = __builtin_amdgcn_mfma_f32_16x16x32_bf16(bfr, af[mb], acc[mb][nb], 0, 0, 0);
        }
    }
#pragma unroll
    for (int mb = 0; mb < 3; ++mb)
#pragma unroll
        for (int nb = 0; nb < NB; ++nb) store(wm * 48 + mb * 16 + fr, (wn * NB + nb) * 16 + 4 * fq, acc[mb][nb]);
    __syncthreads();
}
__device__ __forceinline__ u32x2_t pack4(const f32x4 v) { u32x2_t w; w.x = cvt_pk_bf16(v[0], v[1]); w.y = cvt_pk_bf16(v[2], v[3]); return w; }
struct BRowS1 { const bf16* base; const bf16* row0; __device__ __forceinline__ const bf16* operator()(int kk) const { return kk == 0 ? row0 : base + (size_t)kk * (N2 * 512); } };
struct StoreS1 { bf16* base; int mlim, moff; __device__ __forceinline__ void operator()(int m, int n, const f32x4 v) const { const int mg = moff + m; if (mg < mlim) *(u32x2_t*)(base + (size_t)mg * (N2 * 512) + n) = pack4(v); } };
__device__ __forceinline__ void fft_stage1(const Ptrs& P, LAS unsigned char* lds, int vcu, int G, int tid, int lane, int wave) {
    constexpr int IT_P = NBP * 48, IT_S = NBS * 192 * 4;
    for (int it = vcu; it < IT_P + IT_S; it += G) {
        if (it < IT_P) { const int seq = it / 48, nt = it % 48; const size_t ub = (size_t)useq_base(seq) * 512, yb = (size_t)useq_base(seq) * 1024;
            nn96_item<2, 8>(P.D1P, BRowS1{P.U + ub + nt * 512, nt < NMETA ? P.Um + nt * 512 : P.U + ub + nt * 512}, N1P, StoreS1{P.Y + yb + nt * 512, 2 * N1P, 0}, lds, tid, lane, wave); }
        else { const int i2 = it - IT_P, mc = i2 & 3, nt = (i2 >> 2) % 192, seq = NBP + (i2 >> 2) / 192; const size_t ub = (size_t)useq_base(seq) * 512, yb = (size_t)useq_base(seq) * 1024;
            nn96_item<6, 2>(P.D1S + (size_t)mc * 96 * 192, BRowS1{P.U + ub + nt * 128, (nt >> 2) < NMETA ? P.Um + nt * 128 : P.U + ub + nt * 128}, N1S, StoreS1{P.Y + yb + nt * 128, 2 * N1S, mc * 96}, lds, tid, lane, wave); }
    }
}
struct BRowS2 { const bf16* yr; const bf16* yi; __device__ __forceinline__ const bf16* operator()(int kk) const { return kk < 48 ? yr + (size_t)kk * 512 : yi + (size_t)(kk - 48) * 512; } };
struct StoreS2 { bf16* ab; int k1, N1; __device__ __forceinline__ void operator()(int mm, int n, const f32x4 v) const {
    const int part = mm >= 48, k = k1 + N1 * (mm - 48 * part); if (k >= NMETA) *(u32x2_t*)(ab + (size_t)(k - NMETA) * 1536 + part * 512 + n) = pack4(v); } };
__device__ __forceinline__ void fft_stage2(const Ptrs& P, LAS unsigned char* lds, int vcu, int G, int tid, int lane, int wave) {
    constexpr int IT_P = NBP * N1P, IT_S = NBS * N1S;
    for (int it = vcu; it < IT_P + IT_S; it += G) {
        const bool smp = it >= IT_P; const int i2 = smp ? it - IT_P : it, N1 = smp ? N1S : N1P, seq = smp ? NBP + i2 / N1S : i2 / N1P, k1 = smp ? i2 % N1S : i2 % N1P;
        const size_t yb = (size_t)useq_base(seq) * 1024;
        nn96_item<3, 8>((smp ? P.D2S : P.D2P) + (size_t)k1 * 9216, BRowS2{P.Y + yb + (size_t)(k1 * 48) * 512, P.Y + yb + (size_t)((N1 + k1) * 48) * 512}, 96,
                        StoreS2{P.ACAT + 512 + (size_t)rseq_base(seq) * 1536, k1, N1}, lds, tid, lane, wave);
    }
}

struct Args { const float* in[14]; float* out; unsigned char* ws; int ph_lo, ph_hi; };
__global__ void __launch_bounds__(NWAVES * 64, 2) mk_fwd(Args args) {
    extern __shared__ __attribute__((aligned(16))) unsigned char lds_raw[];
    LAS unsigned char* lds = (LAS unsigned char*)lds_raw;
    volatile LAS unsigned* MISC = (volatile LAS unsigned*)(lds + MISC_OFF);
    const int tid = threadIdx.x, lane = tid & 63, wave = __builtin_amdgcn_readfirstlane(tid >> 6);
    const int G = gridDim.x, bx = blockIdx.x, vcu = (G % 8 == 0) ? (bx % 8) * (G / 8) + bx / 8 : bx;
    unsigned char* ws = args.ws;
    gu32* ctl = (gu32*)(ws + WS_CTL);
    Ptrs P;
    P.xp = args.in[0]; P.xs = args.in[1]; P.meta = args.in[2]; P.gmix = args.in[3]; P.win = args.in[4]; P.bgate = args.in[5]; P.sink = args.in[6]; P.wao = args.in[7];
    P.wf = args.in[8]; P.wout = args.in[9]; P.gmlp = args.in[10]; P.wup = args.in[11]; P.wdn = args.in[12]; P.gfin = args.in[13]; P.out = args.out;
    P.WinT = (bf16*)(ws + WS_WIN); P.WaoT = (bf16*)(ws + WS_WAO); P.WfT = (bf16*)(ws + WS_WF); P.WoutT = (bf16*)(ws + WS_WOUT); P.WupT = (bf16*)(ws + WS_WUP); P.WdnT = (bf16*)(ws + WS_WDN);
    P.Gt = (bf16*)(ws + WS_G); P.Q = (bf16*)(ws + WS_Q); P.K = (bf16*)(ws + WS_K); P.V = (bf16*)(ws + WS_V); P.U = (bf16*)(ws + WS_U); P.ACAT = (bf16*)(ws + WS_ACAT);
    P.MG = (bf16*)(ws + WS_MERGED); P.TT = (bf16*)(ws + WS_TT); P.XN = (bf16*)(ws + WS_XN); P.H1B = (bf16*)(ws + WS_H);
    P.Km = (bf16*)(ws + WS_KMETA); P.Vm = (bf16*)(ws + WS_VMETA); P.Um = (bf16*)(ws + WS_UMETA); P.Y = (bf16*)args.out;
    P.ssq1 = (float*)(ws + WS_SSQ1); P.rope = (float*)(ws + WS_ROPE);
    P.D1P = (bf16*)(ws + WS_D1P); P.D1S = (bf16*)(ws + WS_D1S); P.D2P = (bf16*)(ws + WS_D2P); P.D2S = (bf16*)(ws + WS_D2S);

    for (int u = tid; u < (LDS_BYTES - LDSCTL_OFF) / 4; u += NWAVES * 64) ((LAS unsigned*)(lds + LDSCTL_OFF))[u] = 0u;
    __syncthreads();
    XcdBarrier bar; bar.bar = (unsigned*)(ctl + CW_BAR); bar.x = 0; bar.st = nullptr;
    if (MK_N_LAUNCHES == 1) bar = xcd_barrier_post((unsigned*)(ctl + CW_BAR), MISC + 8);
    const int lo = args.ph_lo, hi = args.ph_hi;
#define IN(k) (lo <= (k) && (k) < hi)
#ifndef PROBE_PHASE
#define PROBE_PHASE (-1)
#endif
#ifndef PROBE_MULT
#define PROBE_MULT 2
#endif
    unsigned long long tph0 = (PROBE_PHASE >= 0) ? rt() : 0ull;
#define PH_END(k) do { if (PROBE_PHASE == (k)) { const unsigned long long t1_ = rt(); const unsigned long long d_ = (t1_ - tph0) * PROBE_MULT; while (rt() - t1_ < d_) __builtin_amdgcn_s_sleep(8); } if (PROBE_PHASE >= 0) tph0 = rt(); } while (0)
#define SEAM(k) do { if (IN(k) && IN((k) + 1)) xcd_barrier(bar); } while (0)
    const int gw = vcu * NWAVES + wave, NGW = G * NWAVES;

    if (IN(0)) { p0_prologue(P, lds, vcu, G, tid, lane, wave); SEAM(0); PH_END(0); }
    if (IN(1)) {
        pg8::Gemm g{P.XN, P.WinT, R + 256, INW, DM, DM}; pg8::StaticOrder S; S.init(R + 256, INW, G, bx);
        EpiIn E{P.Q, P.K, P.V, P.U, P.Gt, P.Km, P.Vm, P.Um, P.bgate, P.rope};
        pg8::gemm_phase<EpiIn, pg8::StaticOrder, true, true>(lds, g, S, E);
        SEAM(1); PH_END(1);
    }
    if (IN(2)) {
        attn_mfma(P, lds, vcu, G, tid, lane, wave);
        fft_stage1(P, lds, vcu, G, tid, lane, wave);
        SEAM(2); PH_END(2);
    }
    if (IN(3)) {
        fft_stage2(P, lds, vcu, G, tid, lane, wave);
        SEAM(3); PH_END(3);
    }
    if (IN(4)) {
        pg8::Gemm g{P.ACAT, P.WaoT, R, DM, 512, 1536}; pg8::StaticOrder S; S.init(R, DM, G, bx);
        EpiAO E{P.Gt, P.out};
        pg8::gemm_phase<EpiAO, pg8::StaticOrder, true, true>(lds, g, S, E);
        SEAM(4); PH_END(4);
    }
    if (IN(5)) {
        pg8::Gemm g{P.ACAT + 512, P.WfT, R, DM, DM, 1536}; pg8::StaticOrder S; S.init(R, DM, G, bx);
        EpiF E{P.Gt, P.out, P.MG};
        pg8::gemm_phase<EpiF, pg8::StaticOrder, true, true>(lds, g, S, E);
        SEAM(5); PH_END(5);
    }
    if (IN(6)) {
        pg8::Gemm g{P.MG, P.WoutT, R, DM, DM, DM}; pg8::StaticOrder S; S.init(R, DM, G, bx);
        EpiOut E{P.xp, P.xs, P.out, P.H1B, P.ssq1};
        pg8::gemm_phase<EpiOut, pg8::StaticOrder, true, true>(lds, g, S, E);
        SEAM(6); PH_END(6);
    }
    if (IN(7)) {
        pg8::Gemm g{P.H1B, P.WupT, R, FFD, DM, DM}; pg8::StaticOrder S; S.init(R, FFD, G, bx);
        EpiUp E{P.ssq1, P.TT};
        pg8::gemm_phase<EpiUp, pg8::StaticOrder, true, true>(lds, g, S, E);
        SEAM(7); PH_END(7);
    }
    if (IN(8)) {
        pg8::Gemm g{P.TT, P.WdnT, R, DM, FFD, FFD}; pg8::StaticOrder S; S.init(R, DM, G, bx);
        EpiDown E{P.out};
        pg8::gemm_phase<EpiDown, pg8::StaticOrder, true, true>(lds, g, S, E);
        SEAM(8); PH_END(8);
    }
    if (IN(9)) {
        for (int r = gw; r < R; r += NGW) {
            GAS f32x4* h4 = (GAS f32x4*)(P.out + (size_t)r * DM) + lane; const GAS f32x4* g4 = (const GAS f32x4*)P.gfin + lane;
            f32x4 v[4]; float s = 0.f;
#pragma unroll
            for (int j = 0; j < 4; ++j) { v[j] = h4[64 * j]; s += (v[j].x * v[j].x + v[j].y * v[j].y) + (v[j].z * v[j].z + v[j].w * v[j].w); }
            const float rinv = 1.0f / sqrtf(wave_sum(s) * (1.0f / DM) + RMS_EPS);
#pragma unroll
            for (int j = 0; j < 4; ++j) h4[64 * j] = v[j] * rinv * g4[64 * j];
        }
        PH_END(9);
    }
#undef IN
#undef SEAM
}

extern "C" void kernel_launch(void* const* d_in, const int* in_sizes, int n_in, void* d_out, int out_size, void* d_ws, size_t ws_size, hipStream_t stream) {
    static int grid = 0;
    if (grid == 0) {
        if (n_in != 14 || in_sizes[0] != RP * DM || in_sizes[1] != RS * DM || out_size != R * DM || ws_size < WS_END) {
            fprintf(stderr, "kernel_launch: unexpected shapes: n_in %d in0 %d in1 %d out %d ws %zu (need >= %zu); nothing launched\n", n_in, n_in > 0 ? in_sizes[0] : -1, n_in > 1 ? in_sizes[1] : -1, out_size, ws_size, (size_t)WS_END);
            grid = -1; return; }
        int dev = 0, cus = 0;
        if (hipGetDevice(&dev) != hipSuccess || hipDeviceGetAttribute(&cus, hipDeviceAttributeMultiprocessorCount, dev) != hipSuccess) { grid = -1; return; }
        if (hipFuncSetAttribute((const void*)mk_fwd, hipFuncAttributeMaxDynamicSharedMemorySize, LDS_BYTES) != hipSuccess) { fprintf(stderr, "kernel_launch: hipFuncSetAttribute failed\n"); grid = -1; return; }
        int per_cu = 0;
        if (hipOccupancyMaxActiveBlocksPerMultiprocessor(&per_cu, (const void*)mk_fwd, NWAVES * 64, LDS_BYTES) != hipSuccess || per_cu < 1)
            fprintf(stderr, "kernel_launch: note: occupancy query reports %d workgroups per CU\n", per_cu);
        (void)hipGetLastError();
        grid = cus;
    }
    if (grid < 0) return;
    if (hipMemsetAsync((char*)d_ws + WS_CTL, 0, CTL_ZERO_BYTES, stream) != hipSuccess) { fprintf(stderr, "kernel_launch: memset failed\n"); return; }
    Args a{};
    for (int i = 0; i < 14; ++i) a.in[i] = (const float*)d_in[i];
    a.out = (float*)d_out; a.ws = (unsigned char*)d_ws;
    if (MK_N_LAUNCHES == 1) { a.ph_lo = 0; a.ph_hi = N_PHASES; hipLaunchKernelGGL(mk_fwd, dim3(grid), dim3(NWAVES * 64), LDS_BYTES, stream, a); }
    else for (int p = 0; p < N_PHASES; ++p) { a.ph_lo = p; a.ph_hi = p + 1; hipLaunchKernelGGL(mk_fwd, dim3(grid), dim3(NWAVES * 64), LDS_BYTES, stream, a); }
    const hipError_t le = hipPeekAtLastError();
    if (le != hipSuccess) fprintf(stderr, "kernel_launch: launch failed: %s\n", hipGetErrorName(le));
}
```
